# Optimizing an MI355X kernel written in HIP

```python
import math
import jax, jax.numpy as jnp
from jax import lax
import numpy as np

D_MODEL = 2048
BATCH = 4
SEQ = 2048
DEPTH = 4

HEAD_DIM = 128
N_HEADS_MOBA = D_MODEL // (2 * HEAD_DIM)
N_HEADS_SB = D_MODEL // (2 * HEAD_DIM)
D_MOBA = N_HEADS_MOBA * HEAD_DIM
D_SB = N_HEADS_SB * HEAD_DIM
D_MIX = D_MOBA + D_SB
D_IN_PROJ = 3 * D_MOBA + 3 * D_SB
MOBA_BLOCK = 256
MOBA_TOPK = 3
MOBA_Q_CHUNK = 32
SB_Q_BLOCK = 128
REL_BUCKETS = 32
REL_MAX_DIST = 128
D_FF = 5632
N_SUBLAYERS = 3
N_MOD = 3
EPS = 1e-6

kernel_name = "hybrid_moba_stickbreaking_macaron_block"


def rmsnorm(x, gain):
    xf = x.astype(jnp.float32)
    y = xf * lax.rsqrt(jnp.mean(xf * xf, axis=-1, keepdims=True) + EPS)
    return (y * gain.astype(jnp.float32)).astype(x.dtype)


def rms_unit(x):
    xf = x.astype(jnp.float32)
    return (xf * lax.rsqrt(jnp.mean(xf * xf, axis=-1, keepdims=True) + EPS)).astype(x.dtype)


def swiglu(h, w_gate, w_up, w_down):
    return (jax.nn.silu(h @ w_gate) * (h @ w_up)) @ w_down


def t5_bucket(dist):
    n = jnp.maximum(dist, 0)
    max_exact = REL_BUCKETS // 2
    nf = jnp.maximum(n, 1).astype(jnp.float32)
    large = max_exact + (jnp.log(nf / max_exact) / math.log(REL_MAX_DIST / max_exact)
                         * (REL_BUCKETS - max_exact)).astype(jnp.int32)
    large = jnp.minimum(large, REL_BUCKETS - 1)
    return jnp.where(n < max_exact, n, large)


def moba_attention(q, k, v, rel_bias):
    B, H, S, Dh = q.shape
    nb = -(-S // MOBA_BLOCK)
    s_pad = nb * MOBA_BLOCK
    pad = ((0, 0), (0, 0), (0, s_pad - S), (0, 0))
    q, k, v = jnp.pad(q, pad), jnp.pad(k, pad), jnp.pad(v, pad)
    k_blk = k.reshape(B, H, nb, MOBA_BLOCK, Dh)
    v_blk = v.reshape(B, H, nb, MOBA_BLOCK, Dh)
    k_mean = jnp.mean(k_blk, axis=3)
    top_k = min(MOBA_TOPK, nb)
    scale = Dh ** -0.5
    bias_t = rel_bias.T.astype(jnp.float32)
    bi = jnp.arange(B)[:, None, None, None]
    hi = jnp.arange(H)[None, :, None, None]
    hi5 = jnp.arange(H)[None, :, None, None, None]
    blk_offsets = jnp.arange(MOBA_BLOCK)

    def chunk(ci):
        q0 = ci * MOBA_Q_CHUNK
        blk = q0 // MOBA_BLOCK
        qc = lax.dynamic_slice_in_dim(q, q0, MOBA_Q_CHUNK, axis=2)
        q_pos = q0 + jnp.arange(MOBA_Q_CHUNK)
        gate = jnp.einsum('bhqd,bhnd->bhqn', qc, k_mean).astype(jnp.float32)
        gate = jnp.where(jnp.arange(nb) < blk, gate, -jnp.inf)
        _, sel = lax.top_k(gate, top_k)
        sel_valid = sel < blk
        k_sel = k_blk[bi, hi, sel]
        v_sel = v_blk[bi, hi, sel]
        s_sel = jnp.einsum('bhqd,bhqnkd->bhqnk', qc, k_sel).astype(jnp.float32) * scale
        k_pos_sel = sel[..., None] * MOBA_BLOCK + blk_offsets
        s_sel = s_sel + bias_t[hi5, t5_bucket(q_pos[None, None, :, None, None] - k_pos_sel)]
        s_sel = jnp.where(sel_valid[..., None], s_sel, -jnp.inf)
        k_own = lax.dynamic_slice_in_dim(k, blk * MOBA_BLOCK, MOBA_BLOCK, axis=2)
        v_own = lax.dynamic_slice_in_dim(v, blk * MOBA_BLOCK, MOBA_BLOCK, axis=2)
        rel_own = q_pos[:, None] - (blk * MOBA_BLOCK + blk_offsets)[None, :]
        s_own = jnp.einsum('bhqd,bhkd->bhqk', qc, k_own).astype(jnp.float32) * scale
        s_own = s_own + bias_t[:, t5_bucket(rel_own)]
        s_own = jnp.where(rel_own >= 0, s_own, -jnp.inf)
        logits = jnp.concatenate([s_sel.reshape(B, H, MOBA_Q_CHUNK, top_k * MOBA_BLOCK), s_own], axis=-1)
        p = jax.nn.softmax(logits, axis=-1)
        p_sel = p[..., :top_k * MOBA_BLOCK].reshape(B, H, MOBA_Q_CHUNK, top_k, MOBA_BLOCK)
        p_own = p[..., top_k * MOBA_BLOCK:]
        out = (jnp.einsum('bhqnk,bhqnkd->bhqd', p_sel.astype(v.dtype), v_sel)
               + jnp.einsum('bhqk,bhkd->bhqd', p_own.astype(v.dtype), v_own))
        return out

    outs = lax.map(chunk, jnp.arange(s_pad // MOBA_Q_CHUNK))
    outs = jnp.transpose(outs, (1, 2, 0, 3, 4)).reshape(B, H, s_pad, Dh)
    return outs[:, :, :S]


def stick_breaking_attention(q, k, v):
    B, H, S, Dh = q.shape
    scale = Dh ** -0.5
    k_pos = jnp.arange(S)

    def block(i):
        q0 = i * SB_Q_BLOCK
        qb = lax.dynamic_slice_in_dim(q, q0, SB_Q_BLOCK, axis=2)
        q_pos = q0 + jnp.arange(SB_Q_BLOCK)
        z = jnp.einsum('bhqd,bhkd->bhqk', qb, k).astype(jnp.float32) * scale
        strict = k_pos[None, :] < q_pos[:, None]
        log_fail = jnp.where(strict, jax.nn.log_sigmoid(-z), 0.0)
        csum = jnp.cumsum(log_fail, axis=-1)
        remaining = csum[..., -1:] - csum
        a = jnp.where(strict, jnp.exp(jax.nn.log_sigmoid(z) + remaining), 0.0)
        return jnp.einsum('bhqk,bhkd->bhqd', a.astype(v.dtype), v)

    outs = lax.map(block, jnp.arange(S // SB_Q_BLOCK))
    return jnp.transpose(outs, (1, 2, 0, 3, 4)).reshape(B, H, S, Dh)


def hybrid_mixer(h, w_in, out_gain, w_out, rel_bias):
    B, S, _ = h.shape
    proj = h @ w_in
    q_a, k_a, v_a, q_b, k_b, v_b = jnp.split(
        proj, [D_MOBA, 2 * D_MOBA, 3 * D_MOBA, 3 * D_MOBA + D_SB, 3 * D_MOBA + 2 * D_SB], axis=-1)

    def heads(t, n):
        return t.reshape(B, S, n, HEAD_DIM).transpose(0, 2, 1, 3)

    o_a = moba_attention(heads(q_a, N_HEADS_MOBA), heads(k_a, N_HEADS_MOBA), heads(v_a, N_HEADS_MOBA), rel_bias)
    o_b = stick_breaking_attention(heads(q_b, N_HEADS_SB), heads(k_b, N_HEADS_SB), heads(v_b, N_HEADS_SB))
    o = rms_unit(jnp.concatenate([o_a, o_b], axis=1))
    o = o.transpose(0, 2, 1, 3).reshape(B, S, D_MIX) * out_gain
    return o @ w_out


def sandwich(x, y_fn, g_pre, g_post, shift, scale, gate, res_w):
    h = rmsnorm(x, g_pre) * (1 + scale[:, None, :]) + shift[:, None, :]
    y = rmsnorm(y_fn(h), g_post)
    return x + res_w * gate[:, None, :] * y


def setup_inputs(seed: int = 0) -> dict:
    key = jax.random.key(seed)
    ks = jax.random.split(key, 16)
    f32 = jnp.float32
    D, F = D_MODEL, D_FF

    def normal(k, shape, s):
        return jax.random.normal(k, shape, f32) * s

    return {
        "x": normal(ks[0], (BATCH, SEQ, D), 1.0),
        "c": normal(ks[1], (BATCH, D), 1.0),
        "ada_w": normal(ks[2], (DEPTH, D, N_SUBLAYERS * N_MOD * D), D ** -0.5),
        "ada_b": normal(ks[3], (DEPTH, N_SUBLAYERS * N_MOD * D), 0.02),
        "norm_pre": 1.0 + normal(ks[4], (DEPTH, N_SUBLAYERS, D), 0.05),
        "norm_post": 1.0 + normal(ks[5], (DEPTH, N_SUBLAYERS, D), 0.05),
        "ffn1_w_gate": normal(ks[6], (DEPTH, D, F), D ** -0.5),
        "ffn1_w_up": normal(ks[7], (DEPTH, D, F), D ** -0.5),
        "ffn1_w_down": normal(ks[8], (DEPTH, F, D), F ** -0.5),
        "mix_w_in": normal(ks[9], (DEPTH, D, D_IN_PROJ), D ** -0.5),
        "mix_out_gain": 1.0 + normal(ks[10], (DEPTH, D_MIX), 0.05),
        "mix_w_out": normal(ks[11], (DEPTH, D_MIX, D), D_MIX ** -0.5),
        "rel_bias": normal(ks[12], (REL_BUCKETS, N_HEADS_MOBA), 0.5),
        "ffn2_w_gate": normal(ks[13], (DEPTH, D, F), D ** -0.5),
        "ffn2_w_up": normal(ks[14], (DEPTH, D, F), D ** -0.5),
        "ffn2_w_down": normal(ks[15], (DEPTH, F, D), F ** -0.5),
    }


def reference(x, c, ada_w, ada_b, norm_pre, norm_post, ffn1_w_gate, ffn1_w_up, ffn1_w_down,
              mix_w_in, mix_out_gain, mix_w_out, rel_bias, ffn2_w_gate, ffn2_w_up, ffn2_w_down):
    B = x.shape[0]
    c_act = jax.nn.silu(c)
    for l in range(DEPTH):
        mod = (c_act @ ada_w[l] + ada_b[l]).reshape(B, N_SUBLAYERS, N_MOD, D_MODEL)
        x = sandwich(x, lambda h: swiglu(h, ffn1_w_gate[l], ffn1_w_up[l], ffn1_w_down[l]),
                     norm_pre[l, 0], norm_post[l, 0], mod[:, 0, 0], mod[:, 0, 1], mod[:, 0, 2], 0.5)
        x = sandwich(x, lambda h: hybrid_mixer(h, mix_w_in[l], mix_out_gain[l], mix_w_out[l], rel_bias),
                     norm_pre[l, 1], norm_post[l, 1], mod[:, 1, 0], mod[:, 1, 1], mod[:, 1, 2], 1.0)
        x = sandwich(x, lambda h: swiglu(h, ffn2_w_gate[l], ffn2_w_up[l], ffn2_w_down[l]),
                     norm_pre[l, 2], norm_post[l, 2], mod[:, 2, 0], mod[:, 2, 1], mod[:, 2, 2], 0.5)
    return x
```

```cpp
#include <hip/hip_runtime.h>
#include <cstdio>
#include <cstdint>

#ifndef MK_PER_PHASE
#define MK_PER_PHASE 0
#endif

namespace pg8 {
#define PG8_LAS __attribute__((address_space(3)))
typedef unsigned short bf16_t;
typedef short bf16x8 __attribute__((ext_vector_type(8)));
typedef float f32x4 __attribute__((ext_vector_type(4)));
typedef unsigned u32x4 __attribute__((ext_vector_type(4)));
constexpr int BM = 256, BK = 64, HALF = 128, HTB = HALF * BK * 2, STAGE_BYTES = 8 * HTB, NXCD = 8, WGM = 8;

__host__ __device__ __forceinline__ int lds_byte(int r, int c) { const int st = (r >> 4) * 2 + (c >> 5), rr = r & 15, cc = c & 31, ob = rr * 64 + cc * 2; return st * 1024 + (ob ^ (((ob >> 9) & 1) << 5)); }
__host__ __device__ __forceinline__ void stage_rc(int b, int& R, int& C) { const int st = b / 1024, sb = b % 1024, swz = sb ^ (((sb >> 9) & 1) << 5); R = (st >> 1) * 16 + swz / 64; C = (st & 1) * 32 + (swz % 64) / 2; }
__host__ __device__ __forceinline__ int perm32(int rho) { const int n = rho >> 4, i = rho & 15; return 8 * (i >> 2) + 4 * n + (i & 3); }

struct Unit { int pm, pn; };
struct Gemm { const bf16_t* A; const bf16_t* Bt; int M, N, K; };

struct StaticOrder {
    int nM, nN, nwg, G, c;
    __host__ __device__ void init(int M, int N, int G_, int c_) { nM = M / BM; nN = N / BM; nwg = nM * nN; G = G_; c = c_; }
    __host__ __device__ bool next(int i, Unit& u) const {
        const long L = (long)i * G + c; if (L >= nwg) return false;
        int wgid = (int)L; { const int q = nwg / NXCD, r = nwg % NXCD, xcd = wgid % NXCD, off = wgid / NXCD; wgid = (xcd < r ? xcd * (q + 1) : r * (q + 1) + (xcd - r) * q) + off; }
        const int nig = WGM * nN, gid = wgid / nig, fm = gid * WGM, gsz = (nM - fm) < WGM ? (nM - fm) : WGM;
        u.pm = fm + ((wgid % nig) % gsz); u.pn = (wgid % nig) / gsz; return true;
    }
    __device__ __forceinline__ void a_ready(const Unit&) const {}
    __device__ __forceinline__ void done(const Unit&) const {}
};

__device__ __forceinline__ unsigned cvt_pk_bf16(float lo, float hi) { unsigned r; asm volatile("v_cvt_pk_bf16_f32 %0, %1, %2" : "=v"(r) : "v"(lo), "v"(hi)); return r; }

struct EpiF32 {
    static constexpr bool PERM = false, AFTER_DRAIN = false;
    float* C; int ldc;
    __device__ __forceinline__ void operator()(const f32x4 (&acc)[2][2][4][2], const Unit& u, int wr, int wc, int fr, int fq) const {
        const int row0 = u.pm * BM + wr * 64 + fr, col0 = u.pn * BM + wc * 32 + 4 * fq;
#pragma unroll
        for (int ai = 0; ai < 2; ++ai)
#pragma unroll
            for (int m = 0; m < 4; ++m) { float* rowp = C + (size_t)(row0 + ai * HALF + m * 16) * ldc + col0;
#pragma unroll
                for (int bj = 0; bj < 2; ++bj)
#pragma unroll
                    for (int n = 0; n < 2; ++n) *(f32x4*)(rowp + bj * HALF + n * 16) = acc[ai][bj][m][n]; }
    }
};
struct EpiBf16 {
    static constexpr bool PERM = true, AFTER_DRAIN = false;
    bf16_t* O; int ldc;
    __device__ __forceinline__ void operator()(const f32x4 (&acc)[2][2][4][2], const Unit& u, int wr, int wc, int fr, int fq) const {
        const int row0 = u.pm * BM + wr * 64 + fr, col0 = u.pn * BM + wc * 32 + 8 * fq;
#pragma unroll
        for (int ai = 0; ai < 2; ++ai)
#pragma unroll
            for (int m = 0; m < 4; ++m) { bf16_t* rowp = O + (size_t)(row0 + ai * HALF + m * 16) * ldc + col0;
#pragma unroll
                for (int bj = 0; bj < 2; ++bj) { const f32x4 v0 = acc[ai][bj][m][0], v1 = acc[ai][bj][m][1];
                    u32x4 w; w.x = cvt_pk_bf16(v0[0], v0[1]); w.y = cvt_pk_bf16(v0[2], v0[3]); w.z = cvt_pk_bf16(v1[0], v1[1]); w.w = cvt_pk_bf16(v1[2], v1[3]);
                    *(u32x4*)(rowp + bj * HALF) = w; } }
    }
};
struct EpiSwiGLU {
    static constexpr bool PERM = true, AFTER_DRAIN = false;
    bf16_t* O; int ldc;
    static __device__ __forceinline__ float swi(float g, float u) { const float e = __builtin_amdgcn_exp2f(-1.4426950408889634f * g); return g * __builtin_amdgcn_rcpf(1.0f + e) * u; }
    __device__ __forceinline__ void operator()(const f32x4 (&acc)[2][2][4][2], const Unit& u, int wr, int wc, int fr, int fq) const {
        const int row0 = u.pm * BM + wr * 64 + fr, col0 = u.pn * HALF + wc * 32 + 8 * fq;
#pragma unroll
        for (int ai = 0; ai < 2; ++ai)
#pragma unroll
            for (int m = 0; m < 4; ++m) { bf16_t* rowp = O + (size_t)(row0 + ai * HALF + m * 16) * ldc + col0;
                const f32x4 g0 = acc[ai][0][m][0], g1 = acc[ai][0][m][1], u0 = acc[ai][1][m][0], u1 = acc[ai][1][m][1];
                u32x4 w; w.x = cvt_pk_bf16(swi(g0[0], u0[0]), swi(g0[1], u0[1])); w.y = cvt_pk_bf16(swi(g0[2], u0[2]), swi(g0[3], u0[3]));
                w.z = cvt_pk_bf16(swi(g1[0], u1[0]), swi(g1[1], u1[1])); w.w = cvt_pk_bf16(swi(g1[2], u1[2]), swi(g1[3], u1[3]));
                *(u32x4*)rowp = w; }
    }
};

template <class Epi, class Sched, bool ALIGN_EPI = false>
__device__ __forceinline__ void gemm_phase(PG8_LAS unsigned char* lds, const Gemm g, const Sched& S, const Epi& E) {
    int tid_ = threadIdx.x; asm volatile("" : "+v"(tid_));
    const int tid = tid_, wid = __builtin_amdgcn_readfirstlane(tid >> 6), lane = tid & 63, wr = wid >> 2, wc = wid & 3, fr = lane & 15, fq = lane >> 4;
    const int K = g.K, nt = K / BK;
    unsigned voffA[2], voffB[2];
#pragma unroll
    for (int i = 0; i < 2; ++i) { int R, C; stage_rc(tid * 16 + i * 8192, R, C); const int Rb = Epi::PERM ? ((R & ~31) + perm32(R & 31)) : R;
        voffA[i] = (unsigned)(R * K + C) * 2u; voffB[i] = (unsigned)(Rb * K + C) * 2u; }
    const size_t kstep = (size_t)(BK * 2);
    const size_t hstep = (size_t)HALF * K * 2;
    const size_t tstep = 2 * hstep;
    const unsigned ldsw = (unsigned)wid * 1024u;
    const int aoff = lds_byte(wr * 64 + fr, fq * 8), boff = lds_byte(wc * 32 + fr, fq * 8);
#define PG8_SA(b, h) (((b) * 2 + (h)) * HTB)
#define PG8_SB(b, h) ((4 + (b) * 2 + (h)) * HTB)
#define PG8_STAGE(bufoff, gbase, voff) do { _Pragma("unroll") for (int _i = 0; _i < 2; ++_i) \
        __builtin_amdgcn_global_load_lds((const unsigned*)((const char*)(gbase) + (voff)[_i]), (PG8_LAS unsigned*)(lds + (bufoff) + ldsw + _i * 8192), 16, 0, 0); } while (0)
#define PG8_LDA(dst, b, h) do { _Pragma("unroll") for (int m = 0; m < 4; ++m) _Pragma("unroll") for (int k = 0; k < 2; ++k) dst[m][k] = *(const PG8_LAS bf16x8*)(lds + PG8_SA(b, h) + aoff + m * 2048 + k * 1024); } while (0)
#define PG8_LDB(dst, b, h) do { _Pragma("unroll") for (int n = 0; n < 2; ++n) _Pragma("unroll") for (int k = 0; k < 2; ++k) dst[n][k] = *(const PG8_LAS bf16x8*)(lds + PG8_SB(b, h) + boff + n * 2048 + k * 1024); } while (0)
#define PG8_MMA(ai, bj, At, Bt) do { __builtin_amdgcn_s_setprio(1); _Pragma("unroll") for (int m = 0; m < 4; ++m) _Pragma("unroll") for (int n = 0; n < 2; ++n) _Pragma("unroll") for (int k = 0; k < 2; ++k) \
        acc[ai][bj][m][n] = __builtin_amdgcn_mfma_f32_16x16x32_bf16(Bt[n][k], At[m][k], acc[ai][bj][m][n], 0, 0, 0); __builtin_amdgcn_s_setprio(0); } while (0)
#define PG8_WAIT_V(n) asm volatile("s_waitcnt vmcnt(" #n ")" ::: "memory")
#define PG8_WAIT_L(n) asm volatile("s_waitcnt lgkmcnt(" #n ")" ::: "memory")
#define PG8_BAR __builtin_amdgcn_s_barrier()
#define PG8_SCHED __builtin_amdgcn_sched_barrier(0)
    Unit cur, nxt; int ui = 0;
    if (!S.next(0, cur)) return;
    f32x4 acc[2][2][4][2];
#pragma unroll
    for (int a = 0; a < 2; ++a)
#pragma unroll
        for (int b = 0; b < 2; ++b)
#pragma unroll
            for (int m = 0; m < 4; ++m)
#pragma unroll
                for (int n = 0; n < 2; ++n) acc[a][b][m][n] = (f32x4){0.f, 0.f, 0.f, 0.f};
    bf16x8 At[4][2], B0[2][2], B1[2][2];
    const char* cA = (const char*)g.A + (size_t)cur.pm * tstep; const char* cB = (const char*)g.Bt + (size_t)cur.pn * tstep;
    S.a_ready(cur);
    PG8_STAGE(PG8_SB(0, 0), cB, voffB); PG8_STAGE(PG8_SB(0, 1), cB + hstep, voffB); PG8_STAGE(PG8_SA(0, 0), cA, voffA); PG8_STAGE(PG8_SA(0, 1), cA + hstep, voffA);
    if (wr == 1) PG8_BAR;
    PG8_WAIT_V(2); PG8_BAR;
    PG8_STAGE(PG8_SB(1, 0), cB + kstep, voffB); PG8_STAGE(PG8_SA(1, 0), cA + kstep, voffA); PG8_STAGE(PG8_SB(1, 1), cB + hstep + kstep, voffB);
    PG8_WAIT_V(6); PG8_BAR;
    for (;;) {
        const bool has_next = S.next(ui + 1, nxt);
        const char* nA = has_next ? (const char*)g.A + (size_t)nxt.pm * tstep : cA; const char* nB = has_next ? (const char*)g.Bt + (size_t)nxt.pn * tstep : cB;
        for (int t = 0; t < nt; t += 2) {
            const bool last = (t == nt - 2);
            const char* a1 = cA + (size_t)(t + 1) * kstep;
            const char* a2 = last ? nA : cA + (size_t)(t + 2) * kstep; const char* b2 = last ? nB : cB + (size_t)(t + 2) * kstep;
            const char* a3 = a2 + kstep; const char* b3 = b2 + kstep;
            if (last && has_next) S.a_ready(nxt);
            PG8_LDB(B0, 0, 0); PG8_LDB(B1, 0, 1); PG8_SCHED; PG8_LDA(At, 0, 0); PG8_STAGE(PG8_SA(1, 1), a1 + hstep, voffA);
            PG8_WAIT_V(8); PG8_WAIT_L(0); PG8_BAR; PG8_MMA(0, 0, At, B0); PG8_MMA(0, 1, At, B1); PG8_BAR; PG8_SCHED;
            PG8_LDA(At, 0, 1); PG8_STAGE(PG8_SB(0, 0), b2, voffB); PG8_STAGE(PG8_SB(0, 1), b2 + hstep, voffB); PG8_STAGE(PG8_SA(0, 0), a2, voffA);
            PG8_WAIT_V(8); PG8_WAIT_L(0); PG8_BAR; PG8_MMA(1, 0, At, B0); PG8_MMA(1, 1, At, B1); PG8_BAR; PG8_SCHED;
            PG8_LDB(B0, 1, 0); PG8_LDB(B1, 1, 1); PG8_SCHED; PG8_LDA(At, 1, 0); PG8_STAGE(PG8_SA(0, 1), a2 + hstep, voffA);
            PG8_WAIT_V(8); PG8_WAIT_L(0); PG8_BAR; PG8_MMA(0, 0, At, B0); PG8_MMA(0, 1, At, B1); PG8_BAR; PG8_SCHED;
            PG8_LDA(At, 1, 1); PG8_STAGE(PG8_SB(1, 0), b3, voffB); PG8_STAGE(PG8_SB(1, 1), b3 + hstep, voffB); PG8_STAGE(PG8_SA(1, 0), a3, voffA);
            PG8_WAIT_V(8); PG8_WAIT_L(0); PG8_BAR; PG8_MMA(1, 0, At, B0); PG8_MMA(1, 1, At, B1); PG8_BAR; PG8_SCHED;
        }
        if constexpr (ALIGN_EPI) { if (wr == 0) PG8_BAR; }
        if constexpr (!Epi::AFTER_DRAIN) { E(acc, cur, wr, wc, fr, fq); S.done(cur); }
        if (!has_next) break;
#pragma unroll
        for (int a = 0; a < 2; ++a)
#pragma unroll
            for (int b = 0; b < 2; ++b)
#pragma unroll
                for (int m = 0; m < 4; ++m)
#pragma unroll
                    for (int n = 0; n < 2; ++n) acc[a][b][m][n] = (f32x4){0.f, 0.f, 0.f, 0.f};
        cur = nxt; cA = nA; cB = nB; ++ui;
        if constexpr (ALIGN_EPI) { if (wr == 1) PG8_BAR; }
    }
    PG8_WAIT_V(0);
    if constexpr (!ALIGN_EPI) { if (wr == 0) PG8_BAR; }
    PG8_BAR;
#undef PG8_SA
#undef PG8_SB
#undef PG8_STAGE
#undef PG8_LDA
#undef PG8_LDB
#undef PG8_MMA
#undef PG8_WAIT_V
#undef PG8_WAIT_L
#undef PG8_BAR
#undef PG8_SCHED
}
}

constexpr int NWAVES = 8;
constexpr int BATCH = 4, SEQ = 2048, DM = 2048, DEPTH = 4, HD = 128, DFF = 5632, DIN = 6144, M = BATCH * SEQ;
constexpr int NMOD = 9 * DM;
constexpr float EPS = 1e-6f;

#define GAS __attribute__((address_space(1)))
#define LAS __attribute__((address_space(3)))
typedef unsigned short bf16;
typedef unsigned v4u __attribute__((ext_vector_type(4)));
typedef float f32x4 __attribute__((ext_vector_type(4)));
typedef short bf16x8 __attribute__((ext_vector_type(8)));
typedef short s16x4 __attribute__((ext_vector_type(4)));
typedef float f32x16 __attribute__((ext_vector_type(16)));

constexpr size_t MiB = 1u << 20;
constexpr size_t WS_CTL = 0, CTL_ZERO_BYTES = 1 * MiB;
constexpr size_t WS_MODP = 2 * MiB;
constexpr size_t WS_TAB = 22 * MiB;
constexpr size_t WS_KMEAN = 24 * MiB;
constexpr size_t WS_H = 26 * MiB;
constexpr size_t WS_Y = 58 * MiB;
constexpr size_t WS_O = 122 * MiB;
constexpr size_t WS_PROJ = 154 * MiB;
constexpr size_t WS_HID = 250 * MiB;
constexpr size_t WS_W = 338 * MiB;
constexpr size_t W_GU1 = 0, W_D1 = 44 * MiB, W_IN = 66 * MiB, W_OUT = 90 * MiB, W_GU2 = 98 * MiB, W_D2 = 142 * MiB, W_LAYER = 164 * MiB;
constexpr size_t WS_END = WS_W + DEPTH * W_LAYER;
constexpr int CW_BAR = 4096;

constexpr int RING_BYTES = 131072;
constexpr int LDSCTL_OFF = RING_BYTES;
constexpr int A_KM = LDSCTL_OFF + 256, A_LUT = A_KM + 4096, A_WS = A_LUT + 1024, A_END = A_WS + 2048;
constexpr int LDS_BYTES = 147456;
static_assert(A_END <= LDS_BYTES, "LDS map");

#define XB_TMO      128
#define XB_XCNT(j)  (256  + 64 * (j))
#define XB_XSUB(j)  (1280 + 64 * (j))
#define XB_XGEN(j)  (2304 + 64 * (j))
#define XB_TOP      3328
#define XB_TOPGEN   3392
#define XCD_BAR_WORDS 3456
#define XB_SPIN_CAP (1u << 22)

__device__ __forceinline__ unsigned xb_ld(unsigned* p)              { return __hip_atomic_load(p, __ATOMIC_RELAXED, __HIP_MEMORY_SCOPE_AGENT); }
__device__ __forceinline__ unsigned xb_add(unsigned* p, unsigned v) { return __hip_atomic_fetch_add(p, v, __ATOMIC_RELAXED, __HIP_MEMORY_SCOPE_AGENT); }
__device__ __forceinline__ unsigned xb_xcc_id() { return (unsigned)__builtin_amdgcn_s_getreg((3 << 11) | 20) & 0xFu; }
#define XB_SPIN(cond, bar) do { unsigned _sp = 0; while (cond) { __builtin_amdgcn_s_sleep(1); \
    if ((++_sp & 255u) == 0u) { if (xb_ld(&(bar)[XB_TMO])) break; if (_sp > XB_SPIN_CAP) { atomicAdd(&(bar)[XB_TMO], 1u); break; } } } } while (0)

struct XcdBarrier { unsigned* bar; unsigned x; volatile LAS unsigned* st; };

__device__ __forceinline__ XcdBarrier xcd_barrier_post(unsigned* bar, volatile LAS unsigned* st) {
    XcdBarrier b; b.bar = bar; b.x = xb_xcc_id(); b.st = st;
    if (threadIdx.x == 0) (void)xb_add(&bar[XB_XCNT(b.x)], 1u);
    return b;
}
__device__ __forceinline__ void xcd_barrier_complete(unsigned* bar, unsigned x, unsigned& nloc, unsigned& nx) {
    const unsigned G = gridDim.x * gridDim.y * gridDim.z;
    unsigned sum, cnt, mine, sp = 0u;
    for (;;) {
        sum = 0u; cnt = 0u; mine = 0u;
#pragma unroll
        for (unsigned j = 0; j < 16; ++j) { const unsigned c = xb_ld(&bar[XB_XCNT(j)]); sum += c; cnt += (c > 0u) ? 1u : 0u; mine = (j == x) ? c : mine; }
        if (sum == G) break;
        __builtin_amdgcn_s_sleep(1);
        if ((++sp & 255u) == 0u) { if (xb_ld(&bar[XB_TMO])) break; if (sp > XB_SPIN_CAP) { atomicAdd(&bar[XB_TMO], 1u); break; } }
    }
    nloc = mine > 0u ? mine : 1u; nx = cnt > 0u ? cnt : 1u;
}
__device__ __forceinline__ void xcd_barrier(const XcdBarrier& b) {
    asm volatile("s_waitcnt vmcnt(0)" ::: "memory");
    __syncthreads();
    if (threadIdx.x == 0) {
        unsigned* bar = b.bar;
        __builtin_amdgcn_s_waitcnt(0);
        unsigned nloc = b.st[0], nx = b.st[1];
        if (nloc == 0u) { xcd_barrier_complete(bar, b.x, nloc, nx); b.st[0] = nloc; b.st[1] = nx; }
        const unsigned old = xb_add(&bar[XB_XSUB(b.x)], 1u);
        const unsigned gen = old / nloc;
        if (old + 1u == (gen + 1u) * nloc) {
            __builtin_amdgcn_fence(__ATOMIC_RELEASE, "agent");
            asm volatile("s_waitcnt vmcnt(0)" ::: "memory");
            const unsigned og = xb_add(&bar[XB_TOP], 1u);
            const unsigned tg = og / nx;
            if (og + 1u == (tg + 1u) * nx) xb_add(&bar[XB_TOPGEN], 1u);
            else XB_SPIN(xb_ld(&bar[XB_TOPGEN]) == tg, bar);
            __builtin_amdgcn_fence(__ATOMIC_ACQUIRE, "agent");
            xb_add(&bar[XB_XGEN(b.x)], 1u);
            asm volatile("s_waitcnt vmcnt(0)" ::: "memory");
        } else {
            XB_SPIN(xb_ld(&bar[XB_XGEN(b.x)]) == gen, bar);
            __builtin_amdgcn_fence(__ATOMIC_ACQUIRE, "agent");
            asm volatile("s_waitcnt vmcnt(0)" ::: "memory");
        }
    }
    __syncthreads();
}

#define LDS_WAIT() asm volatile("s_waitcnt lgkmcnt(0)" ::: "memory")
#define VM_WAIT() asm volatile("s_waitcnt vmcnt(0)" ::: "memory")
__device__ __forceinline__ unsigned f2bf(float f) { unsigned u = __builtin_bit_cast(unsigned, f); return (u + 0x7fffu + ((u >> 16) & 1u)) >> 16; }
__device__ __forceinline__ unsigned pk2(float lo, float hi) { return f2bf(lo) | (f2bf(hi) << 16); }
__device__ __forceinline__ float bf2f(unsigned short b) { return __builtin_bit_cast(float, ((unsigned)b) << 16); }
__device__ __forceinline__ float wave_sum(float v) {
#pragma unroll
    for (int o = 1; o < 64; o <<= 1) v += __shfl_xor(v, o);
    return v;
}
__device__ __forceinline__ float silu_f(float x) { return x / (1.0f + __expf(-x)); }

struct Frame {
    LAS unsigned char* lds;
    int tid, lane, wave, G, gw, NGW;
    const float* in[16]; float* out; unsigned char* ws;
};

__device__ __forceinline__ void p0_transpose_item(const float* W, int K, int N, bf16* WT, int mode, LAS float* scr, int item, int lane) {
    const int nblk = N / 32, kb = item / nblk, nb = item % nblk, k0 = 64 * kb, n0 = 32 * nb;
    const int d0 = mode == 0 ? n0 : ((n0 >> 7) * 256 + (n0 & 127) + (mode == 2 ? 128 : 0));
#pragma unroll 8
    for (int i = 0; i < 32; ++i) { const int kk = 2 * i + (lane >> 5); scr[kk * 33 + (lane & 31)] = __builtin_nontemporal_load(&W[(size_t)(k0 + kk) * N + n0 + (lane & 31)]); }
    LDS_WAIT(); asm volatile("" ::: "memory");
    const int c = lane & 7;
#pragma unroll
    for (int j = 0; j < 4; ++j) { const int n = (lane >> 3) + 8 * j; const LAS float* s = scr + (8 * c) * 33 + n;
        v4u o; o.x = pk2(s[0 * 33], s[1 * 33]); o.y = pk2(s[2 * 33], s[3 * 33]); o.z = pk2(s[4 * 33], s[5 * 33]); o.w = pk2(s[6 * 33], s[7 * 33]);
        *(GAS v4u*)(WT + (size_t)(d0 + n) * K + k0 + 8 * c) = o; }
    LDS_WAIT(); asm volatile("" ::: "memory");
}

__device__ __forceinline__ void p0_ada_item(Frame& F, int item, const LAS float* cact) {
    const int cc = item % 288, kc = item / 288, layer = cc / 72, col0 = (cc % 72) * 256, k0 = kc * 128;
    const float* W = F.in[2] + (size_t)layer * DM * NMOD + (size_t)k0 * NMOD + col0 + 4 * F.lane;
    f32x4 acc[4];
#pragma unroll
    for (int b = 0; b < 4; ++b) acc[b] = (f32x4){0.f, 0.f, 0.f, 0.f};
#pragma unroll 8
    for (int k = 0; k < 128; ++k) {
        const f32x4 w = __builtin_nontemporal_load((const f32x4*)(W + (size_t)k * NMOD));
        const f32x4 ca = *(const LAS f32x4*)(cact + (k0 + k) * 4);
        acc[0] += ca[0] * w; acc[1] += ca[1] * w; acc[2] += ca[2] * w; acc[3] += ca[3] * w;
    }
    float* P = (float*)(F.ws + WS_MODP) + ((size_t)(kc * DEPTH + layer) * BATCH) * NMOD + col0 + 4 * F.lane;
#pragma unroll
    for (int b = 0; b < 4; ++b) *(f32x4*)(P + (size_t)b * NMOD) = acc[b];
}

__device__ __forceinline__ void p0_prologue(Frame& F) {
    LAS float* cact = (LAS float*)(F.lds + 98304);
    for (int i = F.tid; i < BATCH * DM; i += NWAVES * 64) { const int b = i / DM, k = i % DM; cact[k * 4 + b] = silu_f(F.in[1][i]); }
    __syncthreads();
    LAS float* scr = (LAS float*)(F.lds + F.wave * 8704);
    constexpr int N_ADA = 288 * 16;
    constexpr int I_GU = (DM / 64) * (DFF / 32), I_D = (DFF / 64) * (DM / 32), I_IN = (DM / 64) * (DIN / 32), I_OUT = (DM / 64) * (DM / 32);
    constexpr int I_LAYER = 4 * I_GU + 2 * I_D + I_IN + I_OUT;
    constexpr int NITEMS = N_ADA + DEPTH * I_LAYER;
    for (int it = F.gw; it < NITEMS; it += F.NGW) {
        if (it < N_ADA) { p0_ada_item(F, it, cact); continue; }
        int r = it - N_ADA; const int l = r / I_LAYER; r -= l * I_LAYER;
        unsigned char* wl = F.ws + WS_W + (size_t)l * W_LAYER;
        const size_t oGU = (size_t)l * DM * DFF, oD = (size_t)l * DFF * DM;
        if (r < I_GU) { p0_transpose_item(F.in[6] + oGU, DM, DFF, (bf16*)(wl + W_GU1), 1, scr, r, F.lane); continue; } r -= I_GU;
        if (r < I_GU) { p0_transpose_item(F.in[7] + oGU, DM, DFF, (bf16*)(wl + W_GU1), 2, scr, r, F.lane); continue; } r -= I_GU;
        if (r < I_D) { p0_transpose_item(F.in[8] + oD, DFF, DM, (bf16*)(wl + W_D1), 0, scr, r, F.lane); continue; } r -= I_D;
        if (r < I_IN) { p0_transpose_item(F.in[9] + (size_t)l * DM * DIN, DM, DIN, (bf16*)(wl + W_IN), 0, scr, r, F.lane); continue; } r -= I_IN;
        if (r < I_OUT) { p0_transpose_item(F.in[11] + (size_t)l * DM * DM, DM, DM, (bf16*)(wl + W_OUT), 0, scr, r, F.lane); continue; } r -= I_OUT;
        if (r < I_GU) { p0_transpose_item(F.in[13] + oGU, DM, DFF, (bf16*)(wl + W_GU2), 1, scr, r, F.lane); continue; } r -= I_GU;
        if (r < I_GU) { p0_transpose_item(F.in[14] + oGU, DM, DFF, (bf16*)(wl + W_GU2), 2, scr, r, F.lane); continue; } r -= I_GU;
        p0_transpose_item(F.in[15] + oD, DFF, DM, (bf16*)(wl + W_D2), 0, scr, r, F.lane);
    }
}

__device__ __forceinline__ void p0_mod_tables(Frame& F) {
    const float* P = (const float*)(F.ws + WS_MODP); float* T = (float*)(F.ws + WS_TAB);
    const int total = DEPTH * 3 * BATCH * DM;
    for (int i = blockIdx.x * (NWAVES * 64) + F.tid; i < total; i += F.G * NWAVES * 64) {
        const int c = i % DM, b = (i / DM) % BATCH, s = (i / (DM * BATCH)) % 3, l = i / (DM * BATCH * 3);
        float v[3];
#pragma unroll
        for (int j = 0; j < 3; ++j) { const int col = (s * 3 + j) * DM + c; float a = F.in[3][(size_t)l * NMOD + col];
            for (int kc = 0; kc < 16; ++kc) a += P[((size_t)(kc * DEPTH + l) * BATCH + b) * NMOD + col];
            v[j] = a; }
        const float gpre = F.in[4][(size_t)(l * 3 + s) * DM + c], gpost = F.in[5][(size_t)(l * 3 + s) * DM + c];
        float* t = T + ((size_t)((l * 3 + s) * BATCH + b) * 3) * DM + c;
        t[0] = (s == 1 ? 1.0f : 0.5f) * v[2] * gpost; t[DM] = gpre * (1.0f + v[1]); t[2 * DM] = v[0];
    }
}

__device__ __forceinline__ void thin_phase(Frame& F, int ps, int ns) {
    const float* T = (const float*)(F.ws + WS_TAB); const float* Y = (const float*)(F.ws + WS_Y); bf16* H = (bf16*)(F.ws + WS_H);
    const float* xin = ps < 0 ? F.in[0] : F.out;
    for (int m = F.gw * 4; m < M; m += F.NGW * 4) {
#pragma unroll 1
        for (int i = 0; i < 4; ++i) {
            const int row = m + i, b = row / SEQ;
            const GAS f32x4* xr = (const GAS f32x4*)(xin + (size_t)row * DM) + F.lane;
            f32x4 x[8];
#pragma unroll
            for (int j = 0; j < 8; ++j) x[j] = xr[64 * j];
            if (ps >= 0) {
                const GAS f32x4* yr = (const GAS f32x4*)(Y + (size_t)row * DM) + F.lane;
                const GAS f32x4* ta = (const GAS f32x4*)(T + ((size_t)(ps * BATCH + b) * 3) * DM) + F.lane;
                f32x4 y[8]; float ss = 0.f;
#pragma unroll
                for (int j = 0; j < 8; ++j) { y[j] = yr[64 * j]; ss += (y[j].x * y[j].x + y[j].y * y[j].y) + (y[j].z * y[j].z + y[j].w * y[j].w); }
                const float r = 1.0f / sqrtf(wave_sum(ss) * (1.0f / DM) + EPS);
#pragma unroll
                for (int j = 0; j < 8; ++j) x[j] += ta[64 * j] * (y[j] * r);
            }
            if (ps >= 0 || ns == 0) {
                GAS f32x4* xo = (GAS f32x4*)(F.out + (size_t)row * DM) + F.lane;
#pragma unroll
                for (int j = 0; j < 8; ++j) xo[64 * j] = x[j];
            }
            if (ns >= 0) {
                float ss = 0.f;
#pragma unroll
                for (int j = 0; j < 8; ++j) ss += (x[j].x * x[j].x + x[j].y * x[j].y) + (x[j].z * x[j].z + x[j].w * x[j].w);
                const float r = 1.0f / sqrtf(wave_sum(ss) * (1.0f / DM) + EPS);
                const GAS f32x4* tb = (const GAS f32x4*)(T + ((size_t)(ns * BATCH + b) * 3 + 1) * DM) + F.lane;
                const GAS f32x4* tc = (const GAS f32x4*)(T + ((size_t)(ns * BATCH + b) * 3 + 2) * DM) + F.lane;
                GAS unsigned long long* o8 = (GAS unsigned long long*)(H + (size_t)row * DM) + F.lane;
#pragma unroll
                for (int j = 0; j < 8; ++j) { const f32x4 h = (x[j] * r) * tb[64 * j] + tc[64 * j];
                    o8[64 * j] = (unsigned long long)pk2(h.x, h.y) | ((unsigned long long)pk2(h.z, h.w) << 32); }
            }
        }
    }
}

__device__ __forceinline__ void kmean_phase(Frame& F) {
    const bf16* proj = (const bf16*)(F.ws + WS_PROJ); float* KM = (float*)(F.ws + WS_KMEAN);
    LAS float* red = (LAS float*)F.lds;
    for (int it = blockIdx.x; it < BATCH * 8 * 8; it += F.G) {
        const int n = it & 7, hd = (it >> 3) & 7, b = it >> 6;
        const int dp = F.lane, rg = F.wave;
        const bf16* base = proj + ((size_t)b * SEQ + n * 256 + rg * 32) * DIN + 1024 + hd * HD + 2 * dp;
        float a0 = 0.f, a1 = 0.f;
#pragma unroll 8
        for (int r = 0; r < 32; ++r) { const unsigned w = *(const GAS unsigned*)(base + (size_t)r * DIN); a0 += bf2f((unsigned short)(w & 0xffffu)); a1 += bf2f((unsigned short)(w >> 16)); }
        red[rg * 128 + 2 * dp] = a0; red[rg * 128 + 2 * dp + 1] = a1;
        __syncthreads();
        if (F.tid < 128) { float s = 0.f;
#pragma unroll
            for (int g = 0; g < 8; ++g) s += red[g * 128 + F.tid];
            KM[(size_t)it * 128 + F.tid] = s * (1.0f / 256.0f); }
        __syncthreads();
    }
}

namespace att {
constexpr int LDP = DIN, LDO = DM;
constexpr float SCALE = 0.08838834764831845f, LOG2E = 1.4426950408889634f, CS = SCALE * LOG2E;
constexpr int L_V = 0, L_K = 32768, L_OST = 65536, TILE_B = 16384;
#define SBAR() __builtin_amdgcn_sched_barrier(0)
__device__ __forceinline__ int crow(int r, int hi) { return (r & 3) + 8 * (r >> 2) + 4 * hi; }
__device__ __forceinline__ unsigned cvtpk(float lo, float hi) { unsigned r; asm volatile("v_cvt_pk_bf16_f32 %0, %1, %2" : "=v"(r) : "v"(lo), "v"(hi)); return r; }
__device__ __forceinline__ int kf(int row) { return (row & 3) | (((row >> 2) & 1) << 2) | (((row >> 5) & 1) << 3); }
__device__ __forceinline__ int kswz(int row, int colB) { return row * 256 + (colB ^ (kf(row) << 4)); }
__device__ __forceinline__ int v_st(int k, int c) { const int kk = (k & ~0xC) | ((k & 4) << 1) | ((k & 8) >> 1); return ((kk >> 3) * 4 + (c >> 5)) * 512 + ((kk & 7) * 32 + (c & 31)) * 2; }
__device__ __forceinline__ int v_sigma(int a) { return 16 * ((a >> 3) & 3) + 8 * (a >> 5) + (a & 7); }
__device__ __forceinline__ int v_rd_base(int lane) { return ((lane & 3) << 3) | (((lane >> 2) & 3) << 6) | (((lane >> 4) & 1) << 5) | (((lane >> 5) & 1) << 8); }
constexpr int v_rd_off(int d0, int ks, int half) { return d0 * 512 + ks * 4096 + half * 2048; }
template <int OFF> __device__ __forceinline__ s16x4 tr_read(int vb) { s16x4 r; asm volatile("ds_read_b64_tr_b16 %0, %1 offset:%2" : "=&v"(r) : "v"(vb), "i"(OFF) : "memory"); return r; }
template <int D0> __device__ __forceinline__ void pv_one(f32x16& od, int vb, bf16x8 pa0, bf16x8 pa1, bf16x8 pa2, bf16x8 pa3) {
    const s16x4 l0 = tr_read<v_rd_off(D0, 0, 0)>(vb), h0 = tr_read<v_rd_off(D0, 0, 1)>(vb), l1 = tr_read<v_rd_off(D0, 1, 0)>(vb), h1 = tr_read<v_rd_off(D0, 1, 1)>(vb);
    const s16x4 l2 = tr_read<v_rd_off(D0, 2, 0)>(vb), h2 = tr_read<v_rd_off(D0, 2, 1)>(vb), l3 = tr_read<v_rd_off(D0, 3, 0)>(vb), h3 = tr_read<v_rd_off(D0, 3, 1)>(vb);
    asm volatile("s_waitcnt lgkmcnt(0)" ::: "memory"); SBAR();
#define PK(L, H) (bf16x8){L[0], L[1], L[2], L[3], H[0], H[1], H[2], H[3]}
    od = __builtin_amdgcn_mfma_f32_32x32x16_bf16(pa0, PK(l0, h0), od, 0, 0, 0);
    od = __builtin_amdgcn_mfma_f32_32x32x16_bf16(pa1, PK(l1, h1), od, 0, 0, 0);
    od = __builtin_amdgcn_mfma_f32_32x32x16_bf16(pa2, PK(l2, h2), od, 0, 0, 0);
    od = __builtin_amdgcn_mfma_f32_32x32x16_bf16(pa3, PK(l3, h3), od, 0, 0, 0);
#undef PK
}
__device__ __forceinline__ float swap_max(float v) { auto rr = __builtin_amdgcn_permlane32_swap(__float_as_uint(v), __float_as_uint(v), false, false); return fmaxf(__uint_as_float(rr[0]), __uint_as_float(rr[1])); }
__device__ __forceinline__ float swap_add(float v) { auto rr = __builtin_amdgcn_permlane32_swap(__float_as_uint(v), __float_as_uint(v), false, false); return __uint_as_float(rr[0]) + __uint_as_float(rr[1]); }
__device__ __forceinline__ float swap_get(float v, int hi) { auto rr = __builtin_amdgcn_permlane32_swap(__float_as_uint(v), __float_as_uint(v), false, false); return hi ? __uint_as_float(rr[0]) : __uint_as_float(rr[1]); }

template <bool MOBA>
__device__ __forceinline__ void attn_unit(LAS unsigned char* lds, const bf16* __restrict__ proj, bf16* __restrict__ Oout, const float* __restrict__ kmean, const float* __restrict__ rel_bias,
                                          const float* __restrict__ out_gain, int b, int hd, int qblk) {
    int tid_ = threadIdx.x; asm volatile("" : "+v"(tid_));
    const int tid = tid_, wid = __builtin_amdgcn_readfirstlane(tid >> 6), lane = tid & 63, r32 = lane & 31, hi = lane >> 5;
    const int qcol = MOBA ? hd * HD : 3 * 1024 + hd * HD, kcol = qcol + 1024, vcol = qcol + 2048, ocol = (MOBA ? 0 : 1024) + hd * HD;
    const size_t rowb = (size_t)b * SEQ;
    LAS unsigned char* V_lds = lds + L_V; LAS unsigned char* K_lds = lds + L_K;
    LAS float* wsc = (LAS float*)(lds + A_WS) + wid * 64;
    LAS float* km = (LAS float*)(lds + A_KM); LAS float* lut = (LAS float*)(lds + A_LUT);
    const int q0w = qblk * 256 + wid * 32, tq = q0w + r32;
    bf16x8 qr[8];
    { const bf16* Qw = proj + (rowb + tq) * LDP + qcol + hi * 8;
#pragma unroll
      for (int d0 = 0; d0 < 8; ++d0) qr[d0] = *(const GAS bf16x8*)(Qw + d0 * 16); }
    unsigned selmask = 0u;
    if constexpr (MOBA) {
        for (int i = tid; i < 1024; i += NWAVES * 64) km[i] = kmean[(size_t)((b * 8 + hd) * 8) * 128 + i];
        if (tid < 129) { const int n = tid; int bk = n;
            if (n >= 16) { bk = 16 + (int)(logf((float)n / 16.0f) / logf(8.0f) * 16.0f); bk = bk > 31 ? 31 : bk; }
            lut[tid] = rel_bias[bk * 8 + hd] * LOG2E; }
        __syncthreads();
        float gv[7];
#pragma unroll
        for (int n = 0; n < 7; ++n) { float a = 0.f;
            if (n < qblk) {
#pragma unroll
                for (int d0 = 0; d0 < 8; ++d0) { const LAS f32x4* kp = (const LAS f32x4*)(km + n * 128 + d0 * 16 + hi * 8); const f32x4 k0v = kp[0], k1v = kp[1];
                    a += bf2f((unsigned short)qr[d0][0]) * k0v[0] + bf2f((unsigned short)qr[d0][1]) * k0v[1] + bf2f((unsigned short)qr[d0][2]) * k0v[2] + bf2f((unsigned short)qr[d0][3]) * k0v[3]
                       + bf2f((unsigned short)qr[d0][4]) * k1v[0] + bf2f((unsigned short)qr[d0][5]) * k1v[1] + bf2f((unsigned short)qr[d0][6]) * k1v[2] + bf2f((unsigned short)qr[d0][7]) * k1v[3]; }
                a = swap_add(a); }
            gv[n] = a; }
        const int nsel = qblk < 3 ? qblk : 3;
#pragma unroll
        for (int t = 0; t < 3; ++t) { if (t < nsel) { float best = -__builtin_inff(); unsigned bi = 0u;
#pragma unroll
            for (int n = 0; n < 7; ++n) { const bool ok = (n < qblk) && !((selmask >> n) & 1u) && (gv[n] > best); best = ok ? gv[n] : best; bi = ok ? (unsigned)n : bi; }
            selmask |= 1u << bi; } }
    }
    const int kr0 = 32 * ((r32 >> 2) & 1) + (r32 & 3) + 4 * (r32 >> 3);
    const int kbase0 = kr0 * 256, kbase1 = (kr0 + 16) * 256, kxc = (16 * hi) ^ (kf(kr0) << 4);
    const int sr = tid >> 4, sc = (tid & 15) * 8;
    const int vst0 = v_st(v_sigma(sr), sc), vst1 = v_st(v_sigma(32 + sr), sc), kst0 = kswz(sr, sc * 2), kst1 = kswz(32 + sr, sc * 2);
    const int vb0 = (int)(unsigned)(uintptr_t)V_lds + v_rd_base(lane);
    bf16x8 vs0, vs1, ks0, ks1;
    const bf16* Kg = proj + rowb * LDP + kcol + sc; const bf16* Vg = proj + rowb * LDP + vcol + sc;
#define SLOAD(k0) do { vs0 = *(const GAS bf16x8*)(Vg + (size_t)((k0) + sr) * LDP); vs1 = *(const GAS bf16x8*)(Vg + (size_t)((k0) + 32 + sr) * LDP); \
                       ks0 = *(const GAS bf16x8*)(Kg + (size_t)((k0) + sr) * LDP); ks1 = *(const GAS bf16x8*)(Kg + (size_t)((k0) + 32 + sr) * LDP); } while (0)
#define SWRITE(bo) do { *(LAS bf16x8*)(V_lds + (bo) + vst0) = vs0; *(LAS bf16x8*)(V_lds + (bo) + vst1) = vs1; *(LAS bf16x8*)(K_lds + (bo) + kst0) = ks0; *(LAS bf16x8*)(K_lds + (bo) + kst1) = ks1; } while (0)
    f32x16 o[4];
#pragma unroll
    for (int d = 0; d < 4; ++d) o[d] = (f32x16){};
    float m_run = -1e30f, l_run = 0.f, R = 0.f;
    const int jmax = 4 * qblk + 3;
    SLOAD(jmax * 64); VM_WAIT(); SWRITE(0); __syncthreads();
    int bo = 0;
    for (int jt = jmax; jt >= 0; --jt) {
        if (jt > 0) SLOAD((jt - 1) * 64);
        const int k0 = jt * 64, n = jt >> 2; const bool diag = (n == qblk);
        bool active;
        if (diag) active = MOBA ? (64 * (jt & 3) <= wid * 32 + 31) : (64 * (jt & 3) <= wid * 32 + 30);
        else active = MOBA ? (__any((int)((selmask >> n) & 1u)) != 0) : true;
        if (active) {
            f32x16 p0 = (f32x16){}, p1 = (f32x16){};
            { const LAS unsigned char* Kt = K_lds + bo;
#pragma unroll
              for (int d0 = 0; d0 < 8; ++d0) { const int cb = (32 * d0) ^ kxc;
                const bf16x8 a0 = *(const LAS bf16x8*)(Kt + kbase0 + cb), a1 = *(const LAS bf16x8*)(Kt + kbase1 + cb);
                p0 = __builtin_amdgcn_mfma_f32_32x32x16_bf16(a0, qr[d0], p0, 0, 0, 0);
                p1 = __builtin_amdgcn_mfma_f32_32x32x16_bf16(a1, qr[d0], p1, 0, 0, 0); } }
            const int dbase = tq - (k0 + 32 * hi);
            if constexpr (MOBA) {
                const bool sel = diag || ((selmask >> n) & 1u);
                const bool far = (q0w - (k0 + 63)) >= 128;
                const float ninf = -__builtin_inff();
                if (far) { const float bb = lut[128];
#pragma unroll
                    for (int r = 0; r < 16; ++r) { p0[r] = sel ? fmaf(p0[r], CS, bb) : ninf; p1[r] = sel ? fmaf(p1[r], CS, bb) : ninf; }
                } else {
#pragma unroll
                    for (int r = 0; r < 16; ++r) { const int d0_ = dbase - r, d1_ = dbase - 16 - r;
                        const int c0 = d0_ < 0 ? 0 : (d0_ > 128 ? 128 : d0_), c1 = d1_ < 0 ? 0 : (d1_ > 128 ? 128 : d1_);
                        p0[r] = (sel && d0_ >= 0) ? fmaf(p0[r], CS, lut[c0]) : ninf; p1[r] = (sel && d1_ >= 0) ? fmaf(p1[r], CS, lut[c1]) : ninf; }
                }
                float pmax = p0[0];
#pragma unroll
                for (int r = 1; r < 16; ++r) pmax = fmaxf(pmax, p0[r]);
#pragma unroll
                for (int r = 0; r < 16; ++r) pmax = fmaxf(pmax, p1[r]);
                pmax = swap_max(pmax);
                float alpha = 1.f;
                if (!__all(pmax <= m_run + 11.5f)) { const float mn = fmaxf(m_run, pmax); alpha = __builtin_amdgcn_exp2f(m_run - mn); m_run = mn; }
                float ps = 0.f;
#pragma unroll
                for (int r = 0; r < 16; ++r) { p0[r] = __builtin_amdgcn_exp2f(p0[r] - m_run); p1[r] = __builtin_amdgcn_exp2f(p1[r] - m_run); ps += p0[r] + p1[r]; }
                ps = swap_add(ps);
                l_run = l_run * alpha + ps;
                if (__any(alpha < 1.f)) { if (hi == 0) wsc[r32] = alpha; LDS_WAIT();
#pragma unroll
                    for (int r = 0; r < 16; ++r) { const float al = wsc[crow(r, hi)];
#pragma unroll
                        for (int d = 0; d < 4; ++d) o[d][r] *= al; } }
            } else {
                float run = 0.f;
#define SB_ELEM(P, r, DOFF) do { const float y = P[r] * CS; const float e = __builtin_amdgcn_exp2f(-fabsf(y)); const float lg = __builtin_amdgcn_logf(1.0f + e); \
                    float lf = fminf(-y, 0.f) - lg; if (diag) lf = (dbase - (DOFF) - (r) > 0) ? lf : 0.f; run += lf; P[r] = y + run; } while (0)
#pragma unroll
                for (int r = 15; r >= 0; --r) SB_ELEM(p1, r, 16);
#pragma unroll
                for (int r = 15; r >= 0; --r) SB_ELEM(p0, r, 0);
#undef SB_ELEM
                const float tp = swap_get(run, hi);
                const float base = R + (hi == 0 ? tp : 0.f);
                R += run + tp;
#pragma unroll
                for (int r = 0; r < 16; ++r) { float a0 = __builtin_amdgcn_exp2f(p0[r] + base), a1 = __builtin_amdgcn_exp2f(p1[r] + base);
                    if (diag) { a0 = (dbase - r > 0) ? a0 : 0.f; a1 = (dbase - 16 - r > 0) ? a1 : 0.f; }
                    p0[r] = a0; p1[r] = a1; }
            }
            bf16x8 pa0, pa1, pa2, pa3;
            { v4u w;
              w.x = cvtpk(p0[0], p0[1]); w.y = cvtpk(p0[2], p0[3]); w.z = cvtpk(p0[4], p0[5]); w.w = cvtpk(p0[6], p0[7]); pa0 = __builtin_bit_cast(bf16x8, w);
              w.x = cvtpk(p0[8], p0[9]); w.y = cvtpk(p0[10], p0[11]); w.z = cvtpk(p0[12], p0[13]); w.w = cvtpk(p0[14], p0[15]); pa1 = __builtin_bit_cast(bf16x8, w);
              w.x = cvtpk(p1[0], p1[1]); w.y = cvtpk(p1[2], p1[3]); w.z = cvtpk(p1[4], p1[5]); w.w = cvtpk(p1[6], p1[7]); pa2 = __builtin_bit_cast(bf16x8, w);
              w.x = cvtpk(p1[8], p1[9]); w.y = cvtpk(p1[10], p1[11]); w.z = cvtpk(p1[12], p1[13]); w.w = cvtpk(p1[14], p1[15]); pa3 = __builtin_bit_cast(bf16x8, w); }
            const int vb = vb0 + bo;
            pv_one<0>(o[0], vb, pa0, pa1, pa2, pa3); pv_one<1>(o[1], vb, pa0, pa1, pa2, pa3); pv_one<2>(o[2], vb, pa0, pa1, pa2, pa3); pv_one<3>(o[3], vb, pa0, pa1, pa2, pa3);
        }
        if (jt > 0) { VM_WAIT(); SWRITE(bo ^ TILE_B); }
        __syncthreads();
        bo ^= TILE_B;
    }
#undef SLOAD
#undef SWRITE
    float rl[16];
    if constexpr (MOBA) { if (hi == 0) wsc[32 + r32] = l_run; LDS_WAIT();
#pragma unroll
        for (int r = 0; r < 16; ++r) rl[r] = 1.0f / wsc[32 + crow(r, hi)];
    } else {
#pragma unroll
        for (int r = 0; r < 16; ++r) rl[r] = 1.0f;
    }
    float gn[4];
#pragma unroll
    for (int d = 0; d < 4; ++d) gn[d] = out_gain[ocol + 32 * d + r32];
    LAS unsigned char* ost = lds + L_OST + wid * 8192;
#pragma unroll
    for (int r = 0; r < 16; ++r) {
        float v[4]; float ss = 0.f;
#pragma unroll
        for (int d = 0; d < 4; ++d) { v[d] = o[d][r] * rl[r]; ss += v[d] * v[d]; }
        ss += __shfl_xor(ss, 1); ss += __shfl_xor(ss, 2); ss += __shfl_xor(ss, 4); ss += __shfl_xor(ss, 8); ss += __shfl_xor(ss, 16);
        const float rs = 1.0f / sqrtf(ss * (1.0f / HD) + EPS);
#pragma unroll
        for (int d = 0; d < 4; ++d) *(LAS unsigned short*)(ost + crow(r, hi) * 256 + (32 * d + r32) * 2) = (unsigned short)f2bf(v[d] * rs * gn[d]);
    }
    LDS_WAIT(); asm volatile("" ::: "memory");
    { bf16* Ob = Oout + (rowb + q0w) * LDO + ocol;
#pragma unroll
      for (int i = 0; i < 8; ++i) { const int row = (lane >> 4) + 4 * i, ch = lane & 15;
        const v4u w = *(const LAS v4u*)(ost + row * 256 + ch * 16);
        *(GAS v4u*)(Ob + (size_t)row * LDO + ch * 8) = w; } }
    LDS_WAIT(); asm volatile("" ::: "memory");
}
}

struct Args { const float* in[16]; float* out; unsigned char* ws; int ph_lo, ph_hi; };
constexpr int N_PHASES = 3 + DEPTH * 3 * 5;

__global__ void __launch_bounds__(NWAVES * 64, 2) fwd(Args args) {
    extern __shared__ __attribute__((aligned(16))) unsigned char lds_raw[];
    Frame F;
    F.lds = (LAS unsigned char*)lds_raw;
    F.tid = threadIdx.x; F.lane = F.tid & 63; F.wave = __builtin_amdgcn_readfirstlane(F.tid >> 6);
    F.G = gridDim.x; F.gw = blockIdx.x * NWAVES + F.wave; F.NGW = F.G * NWAVES;
#pragma unroll
    for (int i = 0; i < 16; ++i) F.in[i] = args.in[i];
    F.out = args.out; F.ws = args.ws;
    volatile LAS unsigned* MISC = (volatile LAS unsigned*)(F.lds + LDSCTL_OFF);
    if (F.tid < 64) MISC[F.tid] = 0u;
    __syncthreads();
    const int lo = args.ph_lo, hi = args.ph_hi;
    const bool multi = (hi - lo) > 1;
    XcdBarrier bar; bar.bar = (unsigned*)(F.ws + WS_CTL) + CW_BAR; bar.x = 0; bar.st = MISC;
    if (multi) bar = xcd_barrier_post((unsigned*)(F.ws + WS_CTL) + CW_BAR, MISC);
#define IN(k) (lo <= (k) && (k) < hi)
#define SEAM(k) do { if (IN((k) + 1)) xcd_barrier(bar); } while (0)

#ifndef DIS_P0
    if (IN(0)) { p0_prologue(F); SEAM(0); }
#endif
#ifndef DIS_THIN
    if (IN(1)) { p0_mod_tables(F); SEAM(1); }
    if (IN(2)) { thin_phase(F, -1, 0); SEAM(2); }
#endif

    bf16* Hb = (bf16*)(F.ws + WS_H); bf16* HID = (bf16*)(F.ws + WS_HID); bf16* PROJ = (bf16*)(F.ws + WS_PROJ); bf16* Ob = (bf16*)(F.ws + WS_O); float* Yb = (float*)(F.ws + WS_Y);
    for (int l = 0; l < DEPTH; ++l) {
        unsigned char* wl = F.ws + WS_W + (size_t)l * W_LAYER;
        for (int s = 0; s < 3; ++s) {
            const int pb = 3 + (l * 3 + s) * 5;
            if (pb + 5 <= lo || pb >= hi) continue;
            if (s != 1) {
                if (IN(pb)) {
                    pg8::Gemm g{Hb, (const bf16*)(wl + (s == 0 ? W_GU1 : W_GU2)), M, 2 * DFF, DM}; pg8::StaticOrder S; S.init(M, 2 * DFF, F.G, (int)blockIdx.x);
                    pg8::EpiSwiGLU E{HID, DFF};
#ifndef DIS_G1
                    pg8::gemm_phase<pg8::EpiSwiGLU, pg8::StaticOrder, true>(F.lds, g, S, E);
#endif
                    if (IN(pb + 3)) xcd_barrier(bar);
                }
            } else {
                if (IN(pb)) {
                    pg8::Gemm g{Hb, (const bf16*)(wl + W_IN), M, DIN, DM}; pg8::StaticOrder S; S.init(M, DIN, F.G, (int)blockIdx.x);
                    pg8::EpiBf16 E{PROJ, DIN};
#ifndef DIS_G2
                    pg8::gemm_phase<pg8::EpiBf16, pg8::StaticOrder, true>(F.lds, g, S, E);
#endif
                    SEAM(pb);
                }
#ifndef DIS_KM
                if (IN(pb + 1)) { kmean_phase(F); SEAM(pb + 1); }
#endif
                if (IN(pb + 2)) {
                    const float* KM = (const float*)(F.ws + WS_KMEAN); const float* gain = F.in[10] + (size_t)l * DM;
                    for (int u = blockIdx.x; u < 256; u += F.G) {
                        const int b = u >> 6, hd = (u >> 3) & 7, j = u & 7;
#ifndef DIS_MOBA
                        att::attn_unit<true>(F.lds, PROJ, Ob, KM, F.in[12], gain, b, hd, 7 - j);
#endif
                    }
                    for (int u = blockIdx.x; u < 256; u += F.G) {
                        const int b = u >> 6, hd = (u >> 3) & 7, j = u & 7;
#ifndef DIS_SB
                        att::attn_unit<false>(F.lds, PROJ, Ob, KM, F.in[12], gain, b, hd, j);
#endif
                    }
                    SEAM(pb + 2);
                }
            }
            if (IN(pb + 3)) {
                const bf16* A = s == 1 ? Ob : HID; const int K = s == 1 ? DM : DFF;
                const bf16* Bt = (const bf16*)(wl + (s == 0 ? W_D1 : (s == 1 ? W_OUT : W_D2)));
                pg8::Gemm g{A, Bt, M, DM, K}; pg8::StaticOrder S; S.init(M, DM, F.G, (int)blockIdx.x);
                pg8::EpiF32 E{Yb, DM};
#ifndef DIS_G3
                pg8::gemm_phase<pg8::EpiF32, pg8::StaticOrder, false>(F.lds, g, S, E);
#endif
                SEAM(pb + 3);
            }
            if (IN(pb + 4)) {
                const int ps = l * 3 + s, ns = (ps + 1 < DEPTH * 3) ? ps + 1 : -1;
#ifndef DIS_THIN
                thin_phase(F, ps, ns);
#endif
                if (ns >= 0) { if (IN(pb + 5)) xcd_barrier(bar); }
            }
        }
    }
#undef IN
#undef SEAM
}

extern "C" void kernel_launch(void* const* d_in, const int* in_sizes, int n_in, void* d_out, int out_size, void* d_ws, size_t ws_size, hipStream_t stream) {
    static int grid = 0;
    if (grid == 0) {
        if (n_in != 16 || in_sizes[0] != M * DM || out_size != M * DM || ws_size < WS_END) { fprintf(stderr, "kernel_launch: unexpected shapes (n_in %d, in0 %d, out %d, ws %zu; need ws >= %zu)\n", n_in, n_in > 0 ? in_sizes[0] : -1, out_size, ws_size, (size_t)WS_END); grid = -1; return; }
        int dev = 0, cus = 0, per_cu = 0;
        if (hipGetDevice(&dev) != hipSuccess || hipDeviceGetAttribute(&cus, hipDeviceAttributeMultiprocessorCount, dev) != hipSuccess) { grid = -1; return; }
        if (hipFuncSetAttribute((const void*)fwd, hipFuncAttributeMaxDynamicSharedMemorySize, LDS_BYTES) != hipSuccess) { fprintf(stderr, "kernel_launch: hipFuncSetAttribute failed\n"); grid = -1; return; }
        if (hipOccupancyMaxActiveBlocksPerMultiprocessor(&per_cu, (const void*)fwd, NWAVES * 64, LDS_BYTES) != hipSuccess || per_cu < 1) fprintf(stderr, "kernel_launch: occupancy query reports %d blocks per CU\n", per_cu);
        (void)hipGetLastError();
        grid = cus;
    }
    if (grid < 0) return;
    if (hipMemsetAsync((char*)d_ws + WS_CTL, 0, CTL_ZERO_BYTES, stream) != hipSuccess) return;
    Args a{};
    for (int i = 0; i < 16; ++i) a.in[i] = (const float*)d_in[i];
    a.out = (float*)d_out; a.ws = (unsigned char*)d_ws;
#if MK_PER_PHASE
    for (int p = 0; p < N_PHASES; ++p) {
        if (p >= 3) { const int r = (p - 3) % 5, s = ((p - 3) / 5) % 3; if ((s != 1 && (r == 1 || r == 2))) continue; }
        a.ph_lo = p; a.ph_hi = p + 1;
        hipLaunchKernelGGL(fwd, dim3(grid), dim3(NWAVES * 64), LDS_BYTES, stream, a);
    }
#else
    a.ph_lo = 0; a.ph_hi = N_PHASES;
    hipLaunchKernelGGL(fwd, dim3(grid), dim3(NWAVES * 64), LDS_BYTES, stream, a);
#endif
    const hipError_t le = hipPeekAtLastError();
    if (le != hipSuccess) fprintf(stderr, "kernel_launch: launch failed: %s\n", hipGetErrorName(le));
}
```

```cpp
#include <hip/hip_runtime.h>
#include <cstdio>
#include <cstdint>

#ifndef REP_P0
#define REP_P0 1
#endif
#ifndef REP_UP
#define REP_UP 1
#endif
#ifndef REP_DOWN
#define REP_DOWN 1
#endif
#ifndef REP_INP
#define REP_INP 1
#endif
#ifndef REP_ATT
#define REP_ATT 1
#endif
#ifndef PROBE_PH
#define PROBE_PH -1
#endif
#ifndef PROBE_REPS
#define PROBE_REPS 4
#endif
#ifndef DIAG_Q
#define DIAG_Q 0
#endif
#ifndef DIAG_W
#define DIAG_W 0
#endif
#ifndef DIAG_BX
#define DIAG_BX 0
#endif
#ifndef DIAG_SB
#define DIAG_SB 0
#endif
#ifndef MK_PER_PHASE
#define MK_PER_PHASE 0
#endif

namespace pg8 {
#define PG8_LAS __attribute__((address_space(3)))
typedef unsigned short bf16_t;
typedef short bf16x8 __attribute__((ext_vector_type(8)));
typedef float f32x4 __attribute__((ext_vector_type(4)));
typedef unsigned u32x4 __attribute__((ext_vector_type(4)));
constexpr int BM = 256, BK = 64, HALF = 128, HTB = HALF * BK * 2, STAGE_BYTES = 8 * HTB, NXCD = 8, WGM = 8;

__host__ __device__ __forceinline__ int lds_byte(int r, int c) { const int st = (r >> 4) * 2 + (c >> 5), rr = r & 15, cc = c & 31, ob = rr * 64 + cc * 2; return st * 1024 + (ob ^ (((ob >> 9) & 1) << 5)); }
__host__ __device__ __forceinline__ void stage_rc(int b, int& R, int& C) { const int st = b / 1024, sb = b % 1024, swz = sb ^ (((sb >> 9) & 1) << 5); R = (st >> 1) * 16 + swz / 64; C = (st & 1) * 32 + (swz % 64) / 2; }
__host__ __device__ __forceinline__ int perm32(int rho) { const int n = rho >> 4, i = rho & 15; return 8 * (i >> 2) + 4 * n + (i & 3); }

struct Unit { int pm, pn; };
struct Gemm { const bf16_t* A; const bf16_t* Bt; int M, N, K, lda, ldb; };

struct StaticOrder {
    int nM, nN, nwg, G, c;
    __host__ __device__ void init(int M, int N, int G_, int c_) { nM = M / BM; nN = N / BM; nwg = nM * nN; G = G_; c = c_; }
    __host__ __device__ bool next(int i, Unit& u) const {
        const long L = (long)i * G + c; if (L >= nwg) return false;
        int wgid = (int)L; { const int q = nwg / NXCD, r = nwg % NXCD, xcd = wgid % NXCD, off = wgid / NXCD; wgid = (xcd < r ? xcd * (q + 1) : r * (q + 1) + (xcd - r) * q) + off; }
        const int nig = WGM * nN, gid = wgid / nig, fm = gid * WGM, gsz = (nM - fm) < WGM ? (nM - fm) : WGM;
        u.pm = fm + ((wgid % nig) % gsz); u.pn = (wgid % nig) / gsz; return true;
    }
    __device__ __forceinline__ void a_ready(const Unit&) const {}
    __device__ __forceinline__ void done(const Unit&) const {}
};

__device__ __forceinline__ unsigned cvt_pk_bf16(float lo, float hi) { unsigned r; asm volatile("v_cvt_pk_bf16_f32 %0, %1, %2" : "=v"(r) : "v"(lo), "v"(hi)); return r; }

struct EpiF32 {
    static constexpr bool PERM = false, AFTER_DRAIN = false;
    float* C; int ldc;
    __device__ __forceinline__ void operator()(const f32x4 (&acc)[2][2][4][2], const Unit& u, int wr, int wc, int fr, int fq) const {
        const int row0 = u.pm * BM + wr * 64 + fr, col0 = u.pn * BM + wc * 32 + 4 * fq;
#pragma unroll
        for (int ai = 0; ai < 2; ++ai)
#pragma unroll
            for (int m = 0; m < 4; ++m) { float* rowp = C + (size_t)(row0 + ai * HALF + m * 16) * ldc + col0;
#pragma unroll
                for (int bj = 0; bj < 2; ++bj)
#pragma unroll
                    for (int n = 0; n < 2; ++n) *(f32x4*)(rowp + bj * HALF + n * 16) = acc[ai][bj][m][n]; }
    }
};
template <bool WT>
struct EpiBf16 {
    static constexpr bool PERM = true, AFTER_DRAIN = false;
    bf16_t* O; int ldc;
    __device__ __forceinline__ void operator()(const f32x4 (&acc)[2][2][4][2], const Unit& u, int wr, int wc, int fr, int fq) const {
        const int row0 = u.pm * BM + wr * 64 + fr, col0 = u.pn * BM + wc * 32 + 8 * fq;
        __amdgpu_buffer_rsrc_t rsrc;
        if constexpr (WT) rsrc = __builtin_amdgcn_make_buffer_rsrc((void*)O, 0, 0x7fffffff, 0x00020000);
#pragma unroll
        for (int ai = 0; ai < 2; ++ai)
#pragma unroll
            for (int m = 0; m < 4; ++m) { const size_t eoff = (size_t)(row0 + ai * HALF + m * 16) * ldc + col0; bf16_t* rowp = O + eoff;
#pragma unroll
                for (int bj = 0; bj < 2; ++bj) { const f32x4 v0 = acc[ai][bj][m][0], v1 = acc[ai][bj][m][1];
                    u32x4 w; w.x = cvt_pk_bf16(v0[0], v0[1]); w.y = cvt_pk_bf16(v0[2], v0[3]); w.z = cvt_pk_bf16(v1[0], v1[1]); w.w = cvt_pk_bf16(v1[2], v1[3]);
                    if constexpr (WT) __builtin_amdgcn_raw_buffer_store_b128(w, rsrc, (int)((eoff + bj * HALF) * 2), 0, 16);
                    else *(u32x4*)(rowp + bj * HALF) = w; } }
    }
};
struct EpiProj {
    static constexpr bool PERM = true, AFTER_DRAIN = false;
    bf16_t* O; int ldc; float* KM;
    __device__ __forceinline__ void operator()(const f32x4 (&acc)[2][2][4][2], const Unit& u, int wr, int wc, int fr, int fq) const {
        const int row0 = u.pm * BM + wr * 64 + fr, colh = wc * 32 + 8 * fq;
#pragma unroll
        for (int ai = 0; ai < 2; ++ai)
#pragma unroll
            for (int m = 0; m < 4; ++m) { bf16_t* rowp = O + ((size_t)(2 * u.pn) * ldc + (size_t)(row0 + ai * HALF + m * 16)) * 128 + colh;
#pragma unroll
                for (int bj = 0; bj < 2; ++bj) { const f32x4 v0 = acc[ai][bj][m][0], v1 = acc[ai][bj][m][1];
                    u32x4 w; w.x = cvt_pk_bf16(v0[0], v0[1]); w.y = cvt_pk_bf16(v0[2], v0[3]); w.z = cvt_pk_bf16(v1[0], v1[1]); w.w = cvt_pk_bf16(v1[2], v1[3]);
                    *(u32x4*)(rowp + (size_t)bj * ldc * 128) = w; } }
        if (u.pn >= 4 && u.pn < 8) {
#pragma unroll
            for (int bj = 0; bj < 2; ++bj)
#pragma unroll
                for (int n = 0; n < 2; ++n) {
                    f32x4 sm = (acc[0][bj][0][n] + acc[0][bj][1][n]) + (acc[0][bj][2][n] + acc[0][bj][3][n]) + (acc[1][bj][0][n] + acc[1][bj][1][n]) + (acc[1][bj][2][n] + acc[1][bj][3][n]);
#pragma unroll
                    for (int i = 0; i < 4; ++i) { float v = sm[i]; v += __shfl_xor(v, 1); v += __shfl_xor(v, 2); v += __shfl_xor(v, 4); v += __shfl_xor(v, 8); sm[i] = v; }
                    if (fr == 0) { const int ca = (u.pn - 4) * BM + bj * HALF + wc * 32 + 8 * fq + 4 * n;
                        float* dst = KM + ((size_t)(((u.pm >> 3) * 8 + (ca >> 7)) * 8 + (u.pm & 7))) * 128 + (ca & 127);
#pragma unroll
                        for (int i = 0; i < 4; ++i) atomicAdd(dst + i, sm[i] * (1.0f / 256.0f)); }
                }
        }
    }
};
struct EpiSwiGLU {
    static constexpr bool PERM = true, AFTER_DRAIN = false;
    bf16_t* O; int ldc;
    static __device__ __forceinline__ float swi(float g, float u) { const float e = __builtin_amdgcn_exp2f(-1.4426950408889634f * g); return g * __builtin_amdgcn_rcpf(1.0f + e) * u; }
    __device__ __forceinline__ void operator()(const f32x4 (&acc)[2][2][4][2], const Unit& u, int wr, int wc, int fr, int fq) const {
        const int row0 = u.pm * BM + wr * 64 + fr, col0 = u.pn * HALF + wc * 32 + 8 * fq;
#pragma unroll
        for (int ai = 0; ai < 2; ++ai)
#pragma unroll
            for (int m = 0; m < 4; ++m) { bf16_t* rowp = O + (size_t)(row0 + ai * HALF + m * 16) * ldc + col0;
                const f32x4 g0 = acc[ai][0][m][0], g1 = acc[ai][0][m][1], u0 = acc[ai][1][m][0], u1 = acc[ai][1][m][1];
                u32x4 w; w.x = cvt_pk_bf16(swi(g0[0], u0[0]), swi(g0[1], u0[1])); w.y = cvt_pk_bf16(swi(g0[2], u0[2]), swi(g0[3], u0[3]));
                w.z = cvt_pk_bf16(swi(g1[0], u1[0]), swi(g1[1], u1[1])); w.w = cvt_pk_bf16(swi(g1[2], u1[2]), swi(g1[3], u1[3]));
                *(u32x4*)rowp = w; }
    }
};

template <class Epi, class Sched, bool ALIGN_EPI = false>
__device__ __forceinline__ void gemm_phase(PG8_LAS unsigned char* lds, const Gemm g, const Sched& S, const Epi& E) {
    int tid_ = threadIdx.x; asm volatile("" : "+v"(tid_));
    const int tid = tid_, wid = __builtin_amdgcn_readfirstlane(tid >> 6), lane = tid & 63, wr = wid >> 2, wc = wid & 3, fr = lane & 15, fq = lane >> 4;
    const int K = g.K, nt = K / BK;
    unsigned voffA[2], voffB[2];
#pragma unroll
    for (int i = 0; i < 2; ++i) { int R, C; stage_rc(tid * 16 + i * 8192, R, C); const int Rb = Epi::PERM ? ((R & ~31) + perm32(R & 31)) : R;
        voffA[i] = (unsigned)(R * g.lda + C) * 2u; voffB[i] = (unsigned)(Rb * g.ldb + C) * 2u; }
    const size_t kstep = (size_t)(BK * 2);
    const size_t hstepA = (size_t)HALF * g.lda * 2, hstepB = (size_t)HALF * g.ldb * 2;
    const size_t tstepA = 2 * hstepA, tstepB = 2 * hstepB;
    const unsigned ldsw = (unsigned)wid * 1024u;
    const int aoff = lds_byte(wr * 64 + fr, fq * 8), boff = lds_byte(wc * 32 + fr, fq * 8);
#define PG8_SA(b, h) (((b) * 2 + (h)) * HTB)
#define PG8_SB(b, h) ((4 + (b) * 2 + (h)) * HTB)
#define PG8_STAGE(bufoff, gbase, voff) do { _Pragma("unroll") for (int _i = 0; _i < 2; ++_i) \
        __builtin_amdgcn_global_load_lds((const unsigned*)((const char*)(gbase) + (voff)[_i]), (PG8_LAS unsigned*)(lds + (bufoff) + ldsw + _i * 8192), 16, 0, 0); } while (0)
#define PG8_LDA(dst, b, h) do { _Pragma("unroll") for (int m = 0; m < 4; ++m) _Pragma("unroll") for (int k = 0; k < 2; ++k) dst[m][k] = *(const PG8_LAS bf16x8*)(lds + PG8_SA(b, h) + aoff + m * 2048 + k * 1024); } while (0)
#define PG8_LDB(dst, b, h) do { _Pragma("unroll") for (int n = 0; n < 2; ++n) _Pragma("unroll") for (int k = 0; k < 2; ++k) dst[n][k] = *(const PG8_LAS bf16x8*)(lds + PG8_SB(b, h) + boff + n * 2048 + k * 1024); } while (0)
#define PG8_MMA(ai, bj, At, Bt) do { __builtin_amdgcn_s_setprio(1); _Pragma("unroll") for (int m = 0; m < 4; ++m) _Pragma("unroll") for (int n = 0; n < 2; ++n) _Pragma("unroll") for (int k = 0; k < 2; ++k) \
        acc[ai][bj][m][n] = __builtin_amdgcn_mfma_f32_16x16x32_bf16(Bt[n][k], At[m][k], acc[ai][bj][m][n], 0, 0, 0); __builtin_amdgcn_s_setprio(0); } while (0)
#define PG8_WAIT_V(n) asm volatile("s_waitcnt vmcnt(" #n ")" ::: "memory")
#define PG8_WAIT_L(n) asm volatile("s_waitcnt lgkmcnt(" #n ")" ::: "memory")
#define PG8_BAR __builtin_amdgcn_s_barrier()
#define PG8_SCHED __builtin_amdgcn_sched_barrier(0)
    Unit cur, nxt; int ui = 0;
    if (!S.next(0, cur)) return;
    f32x4 acc[2][2][4][2];
#pragma unroll
    for (int a = 0; a < 2; ++a)
#pragma unroll
        for (int b = 0; b < 2; ++b)
#pragma unroll
            for (int m = 0; m < 4; ++m)
#pragma unroll
                for (int n = 0; n < 2; ++n) acc[a][b][m][n] = (f32x4){0.f, 0.f, 0.f, 0.f};
    bf16x8 At[4][2], B0[2][2], B1[2][2];
    const char* cA = (const char*)g.A + (size_t)cur.pm * tstepA; const char* cB = (const char*)g.Bt + (size_t)cur.pn * tstepB;
    S.a_ready(cur);
    PG8_STAGE(PG8_SB(0, 0), cB, voffB); PG8_STAGE(PG8_SB(0, 1), cB + hstepB, voffB); PG8_STAGE(PG8_SA(0, 0), cA, voffA); PG8_STAGE(PG8_SA(0, 1), cA + hstepA, voffA);
    if (wr == 1) PG8_BAR;
    PG8_WAIT_V(2); PG8_BAR;
    PG8_STAGE(PG8_SB(1, 0), cB + kstep, voffB); PG8_STAGE(PG8_SA(1, 0), cA + kstep, voffA); PG8_STAGE(PG8_SB(1, 1), cB + hstepB + kstep, voffB);
    PG8_WAIT_V(6); PG8_BAR;
    for (;;) {
        const bool has_next = S.next(ui + 1, nxt);
        const char* nA = has_next ? (const char*)g.A + (size_t)nxt.pm * tstepA : cA; const char* nB = has_next ? (const char*)g.Bt + (size_t)nxt.pn * tstepB : cB;
        for (int t = 0; t < nt; t += 2) {
            const bool last = (t == nt - 2);
            const char* a1 = cA + (size_t)(t + 1) * kstep;
            const char* a2 = last ? nA : cA + (size_t)(t + 2) * kstep; const char* b2 = last ? nB : cB + (size_t)(t + 2) * kstep;
            const char* a3 = a2 + kstep; const char* b3 = b2 + kstep;
            if (last && has_next) S.a_ready(nxt);
            PG8_LDB(B0, 0, 0); PG8_LDB(B1, 0, 1); PG8_SCHED; PG8_LDA(At, 0, 0); PG8_STAGE(PG8_SA(1, 1), a1 + hstepA, voffA);
            PG8_WAIT_V(8); PG8_WAIT_L(0); PG8_BAR; PG8_MMA(0, 0, At, B0); PG8_MMA(0, 1, At, B1); PG8_BAR; PG8_SCHED;
            PG8_LDA(At, 0, 1); PG8_STAGE(PG8_SB(0, 0), b2, voffB); PG8_STAGE(PG8_SB(0, 1), b2 + hstepB, voffB); PG8_STAGE(PG8_SA(0, 0), a2, voffA);
            PG8_WAIT_V(8); PG8_WAIT_L(0); PG8_BAR; PG8_MMA(1, 0, At, B0); PG8_MMA(1, 1, At, B1); PG8_BAR; PG8_SCHED;
            PG8_LDB(B0, 1, 0); PG8_LDB(B1, 1, 1); PG8_SCHED; PG8_LDA(At, 1, 0); PG8_STAGE(PG8_SA(0, 1), a2 + hstepA, voffA);
            PG8_WAIT_V(8); PG8_WAIT_L(0); PG8_BAR; PG8_MMA(0, 0, At, B0); PG8_MMA(0, 1, At, B1); PG8_BAR; PG8_SCHED;
            PG8_LDA(At, 1, 1); PG8_STAGE(PG8_SB(1, 0), b3, voffB); PG8_STAGE(PG8_SB(1, 1), b3 + hstepB, voffB); PG8_STAGE(PG8_SA(1, 0), a3, voffA);
            PG8_WAIT_V(8); PG8_WAIT_L(0); PG8_BAR; PG8_MMA(1, 0, At, B0); PG8_MMA(1, 1, At, B1); PG8_BAR; PG8_SCHED;
        }
        if constexpr (ALIGN_EPI) { if (wr == 0) PG8_BAR; }
        if constexpr (!Epi::AFTER_DRAIN) { E(acc, cur, wr, wc, fr, fq); S.done(cur); }
        if (!has_next) break;
#pragma unroll
        for (int a = 0; a < 2; ++a)
#pragma unroll
            for (int b = 0; b < 2; ++b)
#pragma unroll
                for (int m = 0; m < 4; ++m)
#pragma unroll
                    for (int n = 0; n < 2; ++n) acc[a][b][m][n] = (f32x4){0.f, 0.f, 0.f, 0.f};
        cur = nxt; cA = nA; cB = nB; ++ui;
        if constexpr (ALIGN_EPI) { if (wr == 1) PG8_BAR; }
    }
    PG8_WAIT_V(0);
    if constexpr (!ALIGN_EPI) { if (wr == 0) PG8_BAR; }
    PG8_BAR;
#undef PG8_SA
#undef PG8_SB
#undef PG8_STAGE
#undef PG8_LDA
#undef PG8_LDB
#undef PG8_MMA
#undef PG8_WAIT_V
#undef PG8_WAIT_L
#undef PG8_BAR
#undef PG8_SCHED
}
}

constexpr int NWAVES = 8;
constexpr int BATCH = 4, SEQ = 2048, DM = 2048, DEPTH = 4, HD = 128, DFF = 5632, DIN = 6144, M = BATCH * SEQ;
constexpr int LDH = DFF + 64;
constexpr int NMOD = 9 * DM;
constexpr float EPS = 1e-6f;

#define GAS __attribute__((address_space(1)))
#define LAS __attribute__((address_space(3)))
typedef unsigned short bf16;
typedef GAS unsigned gu32;
typedef unsigned v4u __attribute__((ext_vector_type(4)));
typedef float f32x4 __attribute__((ext_vector_type(4)));
typedef short bf16x8 __attribute__((ext_vector_type(8)));
typedef short s16x4 __attribute__((ext_vector_type(4)));
typedef float f32x16 __attribute__((ext_vector_type(16)));

constexpr size_t MiB = 1u << 20;
constexpr size_t WS_CTL = 0, CTL_ZERO_BYTES = 1 * MiB;
constexpr size_t WS_MODP = 2 * MiB;
constexpr size_t WS_TAB = 22 * MiB;
constexpr size_t WS_KMEAN = 256 * 1024;
constexpr size_t WS_H = 26 * MiB;
constexpr size_t WS_Y = 58 * MiB;
constexpr size_t WS_O = 122 * MiB;
constexpr size_t WS_PROJ = 154 * MiB;
constexpr size_t WS_HID = 250 * MiB;
constexpr size_t WS_W = 340 * MiB;
constexpr size_t W_GU1 = 0, W_D1 = 44 * MiB, W_IN = 66 * MiB, W_OUT = 90 * MiB, W_GU2 = 98 * MiB, W_D2 = 142 * MiB, W_LAYER = 164 * MiB;
constexpr size_t WS_XB = WS_W + DEPTH * W_LAYER;
constexpr size_t WS_END = WS_XB + 32 * MiB;
constexpr int CW_BAR = 4096;
constexpr size_t WS_PCNT = 32 * 1024;

constexpr int RING_BYTES = 131072;
constexpr int LDSCTL_OFF = RING_BYTES;
constexpr int A_KM = LDSCTL_OFF + 256, A_LUT = A_KM + 4096, A_WS = A_LUT + 1024, A_END = A_WS + 2048;
constexpr int LDS_BYTES = 147456;
static_assert(A_END <= LDS_BYTES, "LDS map");

#define XB_TMO      128
#define XB_XCNT(j)  (256  + 64 * (j))
#define XB_XSUB(j)  (1280 + 64 * (j))
#define XB_XGEN(j)  (2304 + 64 * (j))
#define XB_TOP      3328
#define XB_TOPGEN   3392
#define XCD_BAR_WORDS 3456
#define XB_SPIN_CAP (1u << 22)

__device__ __forceinline__ unsigned xb_ld(unsigned* p)              { return __hip_atomic_load(p, __ATOMIC_RELAXED, __HIP_MEMORY_SCOPE_AGENT); }
__device__ __forceinline__ unsigned xb_add(unsigned* p, unsigned v) { return __hip_atomic_fetch_add(p, v, __ATOMIC_RELAXED, __HIP_MEMORY_SCOPE_AGENT); }
__device__ __forceinline__ unsigned xb_xcc_id() { return (unsigned)__builtin_amdgcn_s_getreg((3 << 11) | 20) & 0xFu; }
#define XB_SPIN(cond, bar) do { unsigned _sp = 0; while (cond) { __builtin_amdgcn_s_sleep(1); \
    if ((++_sp & 255u) == 0u) { if (xb_ld(&(bar)[XB_TMO])) break; if (_sp > XB_SPIN_CAP) { atomicAdd(&(bar)[XB_TMO], 1u); break; } } } } while (0)

struct XcdBarrier { unsigned* bar; unsigned x; volatile LAS unsigned* st; };

__device__ __forceinline__ XcdBarrier xcd_barrier_post(unsigned* bar, volatile LAS unsigned* st) {
    XcdBarrier b; b.bar = bar; b.x = xb_xcc_id(); b.st = st;
    if (threadIdx.x == 0) (void)xb_add(&bar[XB_XCNT(b.x)], 1u);
    return b;
}
__device__ __forceinline__ void xcd_barrier_complete(unsigned* bar, unsigned x, unsigned& nloc, unsigned& nx) {
    const unsigned G = gridDim.x * gridDim.y * gridDim.z;
    unsigned sum, cnt, mine, sp = 0u;
    for (;;) {
        sum = 0u; cnt = 0u; mine = 0u;
#pragma unroll
        for (unsigned j = 0; j < 16; ++j) { const unsigned c = xb_ld(&bar[XB_XCNT(j)]); sum += c; cnt += (c > 0u) ? 1u : 0u; mine = (j == x) ? c : mine; }
        if (sum == G) break;
        __builtin_amdgcn_s_sleep(1);
        if ((++sp & 255u) == 0u) { if (xb_ld(&bar[XB_TMO])) break; if (sp > XB_SPIN_CAP) { atomicAdd(&bar[XB_TMO], 1u); break; } }
    }
    nloc = mine > 0u ? mine : 1u; nx = cnt > 0u ? cnt : 1u;
}
__device__ __forceinline__ void xcd_barrier(const XcdBarrier& b) {
    asm volatile("s_waitcnt vmcnt(0)" ::: "memory");
    __syncthreads();
    if (threadIdx.x == 0) {
        unsigned* bar = b.bar;
        __builtin_amdgcn_s_waitcnt(0);
        unsigned nloc = b.st[0], nx = b.st[1];
        if (nloc == 0u) { xcd_barrier_complete(bar, b.x, nloc, nx); b.st[0] = nloc; b.st[1] = nx; }
        const unsigned old = xb_add(&bar[XB_XSUB(b.x)], 1u);
        const unsigned gen = old / nloc;
        if (old + 1u == (gen + 1u) * nloc) {
            __builtin_amdgcn_fence(__ATOMIC_RELEASE, "agent");
            asm volatile("s_waitcnt vmcnt(0)" ::: "memory");
            const unsigned og = xb_add(&bar[XB_TOP], 1u);
            const unsigned tg = og / nx;
            if (og + 1u == (tg + 1u) * nx) xb_add(&bar[XB_TOPGEN], 1u);
            else XB_SPIN(xb_ld(&bar[XB_TOPGEN]) == tg, bar);
            __builtin_amdgcn_fence(__ATOMIC_ACQUIRE, "agent");
            xb_add(&bar[XB_XGEN(b.x)], 1u);
            asm volatile("s_waitcnt vmcnt(0)" ::: "memory");
        } else {
            XB_SPIN(xb_ld(&bar[XB_XGEN(b.x)]) == gen, bar);
            __builtin_amdgcn_fence(__ATOMIC_ACQUIRE, "agent");
            asm volatile("s_waitcnt vmcnt(0)" ::: "memory");
        }
    }
    __syncthreads();
}

#define LDS_WAIT() asm volatile("s_waitcnt lgkmcnt(0)" ::: "memory")
#define VM_WAIT() asm volatile("s_waitcnt vmcnt(0)" ::: "memory")
__device__ __forceinline__ unsigned f2bf(float f) { unsigned u = __builtin_bit_cast(unsigned, f); return (u + 0x7fffu + ((u >> 16) & 1u)) >> 16; }
__device__ __forceinline__ unsigned pk2(float lo, float hi) { return f2bf(lo) | (f2bf(hi) << 16); }
__device__ __forceinline__ float bf2f(unsigned short b) { return __builtin_bit_cast(float, ((unsigned)b) << 16); }
__device__ __forceinline__ float wave_sum(float v) {
#define WS_DPP(x, ctrl, rmask) __builtin_bit_cast(float, __builtin_amdgcn_update_dpp(0, __builtin_bit_cast(int, (x)), (ctrl), (rmask), 0xf, true))
    v += WS_DPP(v, 0x111, 0xf);
    v += WS_DPP(v, 0x112, 0xf);
    v += WS_DPP(v, 0x114, 0xf);
    v += WS_DPP(v, 0x118, 0xf);
    v += WS_DPP(v, 0x142, 0xa);
    v += WS_DPP(v, 0x143, 0xc);
#undef WS_DPP
    return __builtin_bit_cast(float, __builtin_amdgcn_readlane(__builtin_bit_cast(int, v), 63));
}
__device__ __forceinline__ float silu_f(float x) { return x / (1.0f + __expf(-x)); }

struct Frame {
    LAS unsigned char* lds;
    int tid, lane, wave, G, gw, NGW;
    float* out; unsigned char* ws;
    const __attribute__((address_space(4))) unsigned long long* inp;
    __device__ __forceinline__ const float* in(int i) const { const __attribute__((address_space(4))) unsigned long long* p = inp; asm volatile("" : "+s"(p)); return (const float*)(const GAS float*)p[i]; }
};

__device__ __forceinline__ void p0_transpose_item(const float* W, int K, int N, bf16* WT, int mode, LAS unsigned char* scr, int item, int lane) {
    const int nblk = N / 64, kb = item / nblk, nb = item % nblk, k0 = 64 * kb, n0 = 64 * nb;
    const int d0 = mode == 0 ? n0 : ((n0 >> 7) * 256 + (n0 & 127) + (mode == 2 ? 128 : 0));
    const int kq = lane >> 4, nq = 4 * (lane & 15);
    const float* src = W + (size_t)(k0 + 2 * kq) * N + n0 + nq;
    f32x4 va[8], vb[8];
#pragma unroll
    for (int i = 0; i < 8; ++i) { va[i] = __builtin_nontemporal_load((const f32x4*)(src + (size_t)(8 * i) * N)); vb[i] = __builtin_nontemporal_load((const f32x4*)(src + (size_t)(8 * i + 1) * N)); }
#pragma unroll
    for (int i = 0; i < 8; ++i) {
#pragma unroll
        for (int c = 0; c < 4; ++c) *(LAS unsigned*)(scr + (nq + c) * 136 + (8 * i + 2 * kq) * 2) = pk2(va[i][c], vb[i][c]); }
    LDS_WAIT(); asm volatile("" ::: "memory");
    const int ch = lane & 7;
#pragma unroll
    for (int j = 0; j < 8; ++j) { const int n = 8 * j + (lane >> 3);
        const LAS unsigned long long* p = (const LAS unsigned long long*)(scr + n * 136 + ch * 16);
        const unsigned long long lo = p[0], hi2 = p[1];
        v4u o; o.x = (unsigned)lo; o.y = (unsigned)(lo >> 32); o.z = (unsigned)hi2; o.w = (unsigned)(hi2 >> 32);
        *(GAS v4u*)(WT + (size_t)(d0 + n) * K + k0 + 8 * ch) = o; }
    LDS_WAIT(); asm volatile("" ::: "memory");
}

__device__ __forceinline__ void p0_ada_item(Frame& F, int item, const LAS float* cact) {
    const int cc = item % 288, kc = item / 288, layer = cc / 72, col0 = (cc % 72) * 256, k0 = kc * 128;
    const float* W = F.in(2) + (size_t)layer * DM * NMOD + (size_t)k0 * NMOD + col0 + 4 * F.lane;
    f32x4 acc[4];
#pragma unroll
    for (int b = 0; b < 4; ++b) acc[b] = (f32x4){0.f, 0.f, 0.f, 0.f};
#pragma unroll 8
    for (int k = 0; k < 128; ++k) {
        const f32x4 w = __builtin_nontemporal_load((const f32x4*)(W + (size_t)k * NMOD));
        const f32x4 ca = *(const LAS f32x4*)(cact + (k0 + k) * 4);
        acc[0] += ca[0] * w; acc[1] += ca[1] * w; acc[2] += ca[2] * w; acc[3] += ca[3] * w;
    }
    float* P = (float*)(F.ws + WS_MODP) + ((size_t)(kc * DEPTH + layer) * BATCH) * NMOD + col0 + 4 * F.lane;
#pragma unroll
    for (int b = 0; b < 4; ++b) *(f32x4*)(P + (size_t)b * NMOD) = acc[b];
}

constexpr int P0_N_ADA = 288 * 16;
constexpr int P0_I_GU = (DM / 64) * (DFF / 64), P0_I_D = (DFF / 64) * (DM / 64), P0_I_IN = (DM / 64) * (DIN / 64), P0_I_OUT = (DM / 64) * (DM / 64);
constexpr int P0_I_LAYER = 4 * P0_I_GU + 2 * P0_I_D + P0_I_IN + P0_I_OUT;
#ifndef HIDE_H
#define HIDE_H 6656
#endif
constexpr int HIDE_T = 2048;
constexpr int HIDE_WGS = 16;
constexpr int HIDE_N = HIDE_H + HIDE_T;
__host__ __device__ constexpr int hide_cut(int k) { return (k >> 1) * P0_I_LAYER + ((k & 1) ? (4 * P0_I_GU + P0_I_D + P0_I_IN + P0_I_OUT) : 2 * P0_I_GU); }
#ifndef HIDE_NE
#define HIDE_NE 10496
#endif
#ifndef HIDE_NO
#define HIDE_NO 10496
#endif
__host__ __device__ constexpr int hide_cap(int k) { return HIDE_N == 0 ? 0 : (k == 0 ? 12544 : ((k & 1) ? HIDE_NO : HIDE_NE)); }
__host__ __device__ constexpr int hide_start(int k) { int e = 0, st = 0; for (int i = 0; i <= k; ++i) { st = hide_cut(i) > e ? hide_cut(i) : e; e = st + hide_cap(i); if (e > DEPTH * P0_I_LAYER) e = DEPTH * P0_I_LAYER; } return st; }
__host__ __device__ constexpr int hide_len(int k) { const int st = hide_start(k); const int e = st + hide_cap(k) > DEPTH * P0_I_LAYER ? DEPTH * P0_I_LAYER : st + hide_cap(k); return e > st ? e - st : 0; }
__device__ __forceinline__ void p0_layer_item(Frame& F, int l, int r, LAS unsigned char* scr, int lane) {
    unsigned char* wl = F.ws + WS_W + (size_t)l * W_LAYER;
    const size_t oGU = (size_t)l * DM * DFF, oD = (size_t)l * DFF * DM;
    if (r < P0_I_GU) { p0_transpose_item(F.in(6) + oGU, DM, DFF, (bf16*)(wl + W_GU1), 1, scr, r, lane); return; } r -= P0_I_GU;
    if (r < P0_I_GU) { p0_transpose_item(F.in(7) + oGU, DM, DFF, (bf16*)(wl + W_GU1), 2, scr, r, lane); return; } r -= P0_I_GU;
    if (r < P0_I_D) { p0_transpose_item(F.in(8) + oD, DFF, DM, (bf16*)(wl + W_D1), 0, scr, r, lane); return; } r -= P0_I_D;
    if (r < P0_I_IN) { p0_transpose_item(F.in(9) + (size_t)l * DM * DIN, DM, DIN, (bf16*)(wl + W_IN), 0, scr, r, lane); return; } r -= P0_I_IN;
    if (r < P0_I_OUT) { p0_transpose_item(F.in(11) + (size_t)l * DM * DM, DM, DM, (bf16*)(wl + W_OUT), 0, scr, r, lane); return; } r -= P0_I_OUT;
    if (r < P0_I_GU) { p0_transpose_item(F.in(13) + oGU, DM, DFF, (bf16*)(wl + W_GU2), 1, scr, r, lane); return; } r -= P0_I_GU;
    if (r < P0_I_GU) { p0_transpose_item(F.in(14) + oGU, DM, DFF, (bf16*)(wl + W_GU2), 2, scr, r, lane); return; } r -= P0_I_GU;
    p0_transpose_item(F.in(15) + oD, DFF, DM, (bf16*)(wl + W_D2), 0, scr, r, lane);
}
struct TDesc { const float* src; bf16* dst; int N, K; };
__device__ __forceinline__ TDesc t_decode(Frame& F, int g, int lane) {
    const int l = g / P0_I_LAYER; int r = g % P0_I_LAYER;
    unsigned char* wl = F.ws + WS_W + (size_t)l * W_LAYER;
    const size_t oGU = (size_t)l * DM * DFF, oD = (size_t)l * DFF * DM;
    const float* W; bf16* WT; int K, N, mode;
    if (r < P0_I_GU) { W = F.in(6) + oGU; K = DM; N = DFF; WT = (bf16*)(wl + W_GU1); mode = 1; }
    else if ((r -= P0_I_GU) < P0_I_GU) { W = F.in(7) + oGU; K = DM; N = DFF; WT = (bf16*)(wl + W_GU1); mode = 2; }
    else if ((r -= P0_I_GU) < P0_I_D) { W = F.in(8) + oD; K = DFF; N = DM; WT = (bf16*)(wl + W_D1); mode = 0; }
    else if ((r -= P0_I_D) < P0_I_IN) { W = F.in(9) + (size_t)l * DM * DIN; K = DM; N = DIN; WT = (bf16*)(wl + W_IN); mode = 0; }
    else if ((r -= P0_I_IN) < P0_I_OUT) { W = F.in(11) + (size_t)l * DM * DM; K = DM; N = DM; WT = (bf16*)(wl + W_OUT); mode = 0; }
    else if ((r -= P0_I_OUT) < P0_I_GU) { W = F.in(13) + oGU; K = DM; N = DFF; WT = (bf16*)(wl + W_GU2); mode = 1; }
    else if ((r -= P0_I_GU) < P0_I_GU) { W = F.in(14) + oGU; K = DM; N = DFF; WT = (bf16*)(wl + W_GU2); mode = 2; }
    else { r -= P0_I_GU; W = F.in(15) + oD; K = DFF; N = DM; WT = (bf16*)(wl + W_D2); mode = 0; }
    const int nblk = N / 64, kb = r / nblk, nb = r % nblk, k0 = 64 * kb, n0 = 64 * nb;
    const int d0 = mode == 0 ? n0 : ((n0 >> 7) * 256 + (n0 & 127) + (mode == 2 ? 128 : 0));
    TDesc d; d.N = N; d.K = K;
    d.src = W + (size_t)(k0 + 2 * (lane >> 4)) * N + n0 + 4 * (lane & 15);
    d.dst = WT + (size_t)(d0 + (lane >> 3)) * K + k0 + 8 * (lane & 7);
    return d;
}
__device__ __forceinline__ void t_load(const TDesc& d, f32x4 (&va)[8], f32x4 (&vb)[8]) {
#pragma unroll
    for (int i = 0; i < 8; ++i) { va[i] = __builtin_nontemporal_load((const f32x4*)(d.src + (size_t)(8 * i) * d.N)); vb[i] = __builtin_nontemporal_load((const f32x4*)(d.src + (size_t)(8 * i + 1) * d.N)); }
}
__device__ __forceinline__ void t_lds_write(LAS unsigned char* scr, const f32x4 (&va)[8], const f32x4 (&vb)[8], int lane) {
    const int kq = lane >> 4, nq = 4 * (lane & 15);
#pragma unroll
    for (int i = 0; i < 8; ++i) {
#pragma unroll
        for (int c = 0; c < 4; ++c) *(LAS unsigned*)(scr + (nq + c) * 136 + (8 * i + 2 * kq) * 2) = pg8::cvt_pk_bf16(va[i][c], vb[i][c]); }
}
__device__ __forceinline__ void t_store(const LAS unsigned char* scr, const TDesc& d, int lane) {
    const int ch = lane & 7;
#pragma unroll
    for (int j = 0; j < 8; ++j) { const int n = 8 * j + (lane >> 3);
        const LAS unsigned long long* p = (const LAS unsigned long long*)(scr + n * 136 + ch * 16);
        const unsigned long long lo = p[0], hi2 = p[1];
        v4u o; o.x = (unsigned)lo; o.y = (unsigned)(lo >> 32); o.z = (unsigned)hi2; o.w = (unsigned)(hi2 >> 32);
        *(GAS v4u*)(d.dst + (size_t)(8 * j) * d.K) = o; }
}
template <bool SKIP> __device__ __forceinline__ int t_index(int it, int first) {
    int g = first + it;
    if (SKIP) {
#pragma unroll
        for (int k = 0; k < 2 * DEPTH; ++k) if (g >= hide_start(k)) g += hide_len(k); }
    return g;
}
template <bool SKIP, bool DEEP = false> __device__ __forceinline__ void convert_list(Frame& F, int first, int count, int cw, int ncw) {
    LAS unsigned char* scr = F.lds + F.wave * 8704;
    int lane_ = F.lane; asm volatile("" : "+v"(lane_));
    const int lane = lane_;
    if (cw >= count) return;
    if constexpr (DEEP) {
        f32x4 a0[8], b0[8], a1[8], b1[8];
        TDesc d0 = t_decode(F, t_index<SKIP>(cw, first), lane), d1 = d0;
        t_load(d0, a0, b0);
        if (cw + ncw < count) { d1 = t_decode(F, t_index<SKIP>(cw + ncw, first), lane); t_load(d1, a1, b1); }
        for (int it = cw; it < count; it += 2 * ncw) {
            { t_lds_write(scr, a0, b0, lane); const TDesc dc = d0;
              if (it + 2 * ncw < count) { d0 = t_decode(F, t_index<SKIP>(it + 2 * ncw, first), lane); t_load(d0, a0, b0); }
              LDS_WAIT(); asm volatile("" ::: "memory"); t_store(scr, dc, lane); LDS_WAIT(); asm volatile("" ::: "memory"); }
            if (it + ncw < count) { t_lds_write(scr, a1, b1, lane); const TDesc dc = d1;
              if (it + 3 * ncw < count) { d1 = t_decode(F, t_index<SKIP>(it + 3 * ncw, first), lane); t_load(d1, a1, b1); }
              LDS_WAIT(); asm volatile("" ::: "memory"); t_store(scr, dc, lane); LDS_WAIT(); asm volatile("" ::: "memory"); }
        }
    } else {
        f32x4 va[8], vb[8];
        TDesc d = t_decode(F, t_index<SKIP>(cw, first), lane), dn = d;
        t_load(d, va, vb);
        for (int it = cw; it < count; it += ncw) {
            t_lds_write(scr, va, vb, lane);
            const bool more = it + ncw < count;
            if (more) { dn = t_decode(F, t_index<SKIP>(it + ncw, first), lane); t_load(dn, va, vb); }
            LDS_WAIT(); asm volatile("" ::: "memory");
            t_store(scr, d, lane);
            LDS_WAIT(); asm volatile("" ::: "memory");
            d = dn;
        }
    }
}
__device__ __forceinline__ void p0_hidden(Frame& F, int first, int count, int cw, int ncw) {
    convert_list<false>(F, first, count, cw, ncw);
}
template <bool SPARE> __device__ __forceinline__ void convert_dynamic(Frame& F, int first, int count, unsigned* ctr) {
    volatile LAS unsigned* slot = (volatile LAS unsigned*)(F.lds + LDSCTL_OFF) + 5;
    unsigned grab = SPARE ? 16u : 1u;
    for (;;) {
        if (F.tid == 0) slot[0] = __hip_atomic_fetch_add(ctr, grab, __ATOMIC_RELAXED, __HIP_MEMORY_SCOPE_AGENT);
        __syncthreads();
        const int u0 = (int)slot[0] * 8;
        if (u0 >= count) break;
        const int n = (int)grab * 8 < count - u0 ? (int)grab * 8 : count - u0;
        convert_list<false, SPARE>(F, first + u0, n, F.wave, NWAVES);
        if (SPARE) { const int rem = (count - u0 - n) >> 9; grab = rem < 1 ? 1u : (rem > 16 ? 16u : (unsigned)rem); }
        __syncthreads();
    }
}
__device__ __forceinline__ void p0_prologue(Frame& F) {
    LAS float* cact = (LAS float*)(F.lds + 98304);
    for (int i = F.tid; i < BATCH * DM; i += NWAVES * 64) { const int b = i / DM, k = i % DM; cact[k * 4 + b] = silu_f(F.in(1)[i]); }
    __syncthreads();
    const bool hiding = (F.G == 256) && (HIDE_N > 0);
    int nhid = 0;
    if (hiding) {
#pragma unroll
        for (int k = 0; k < 2 * DEPTH; ++k) nhid += hide_len(k); }
    for (int it = F.gw; it < P0_N_ADA; it += F.NGW) p0_ada_item(F, it, cact);
    const int nlist = DEPTH * P0_I_LAYER - nhid;
    if (hiding) {
        const int nheavy = P0_N_ADA % F.NGW, nlight = F.NGW - nheavy;
        int pre = 5 * nlight; if (pre > nlist) pre = nlist;
        if (F.gw >= nheavy) convert_list<true>(F, 0, pre, F.gw - nheavy, nlight);
        convert_list<true>(F, pre, nlist - pre, F.gw, F.NGW);
    } else convert_list<false>(F, 0, nlist, F.gw, F.NGW);
}

__device__ __forceinline__ void p0_mod_tables(Frame& F) {
    const float* P = (const float*)(F.ws + WS_MODP); float* T = (float*)(F.ws + WS_TAB);
    const int total = DEPTH * 3 * BATCH * DM;
    for (int i = blockIdx.x * (NWAVES * 64) + F.tid; i < total; i += F.G * NWAVES * 64) {
        const int c = i % DM, b = (i / DM) % BATCH, s = (i / (DM * BATCH)) % 3, l = i / (DM * BATCH * 3);
        float v[3];
#pragma unroll
        for (int j = 0; j < 3; ++j) { const int col = (s * 3 + j) * DM + c; float a = F.in(3)[(size_t)l * NMOD + col];
            for (int kc = 0; kc < 16; ++kc) a += P[((size_t)(kc * DEPTH + l) * BATCH + b) * NMOD + col];
            v[j] = a; }
        const float gpre = F.in(4)[(size_t)(l * 3 + s) * DM + c], gpost = F.in(5)[(size_t)(l * 3 + s) * DM + c];
        float* t = T + ((size_t)((l * 3 + s) * BATCH + b) * 3) * DM + c;
        t[0] = (s == 1 ? 1.0f : 0.5f) * v[2] * gpost; t[DM] = gpre * (1.0f + v[1]); t[2 * DM] = v[0];
    }
}

__device__ __forceinline__ void thin_phase(Frame& F, int ps, int ns, int rows0) {
    const float* T = (const float*)(F.ws + WS_TAB); const bf16* Y = (const bf16*)(F.ws + WS_Y); bf16* H = (bf16*)(F.ws + WS_H); bf16* XB = (bf16*)(F.ws + WS_XB);
    const float* xin = F.in(0);
    int lane_ = F.lane; asm volatile("" : "+v"(lane_));
    const int lane = lane_;
#define UNPK4(w) (f32x4){bf2f((unsigned short)((w) & 0xffffu)), bf2f((unsigned short)(((w) >> 16) & 0xffffu)), bf2f((unsigned short)(((w) >> 32) & 0xffffu)), bf2f((unsigned short)((w) >> 48))}
    for (int m = (rows0 >= 0 ? rows0 : F.gw * 4); m < (rows0 >= 0 ? rows0 + 4 : M); m += F.NGW * 4) {
#pragma unroll 1
        for (int i = 0; i < 4; ++i) {
            const int row = m + i, b = row / SEQ;
            f32x4 x[8];
            if (ps < 0) { const GAS f32x4* xr = (const GAS f32x4*)(xin + (size_t)row * DM) + lane;
#pragma unroll
                for (int j = 0; j < 8; ++j) x[j] = xr[64 * j];
            } else { const GAS unsigned long long* xr = (const GAS unsigned long long*)(XB + (size_t)row * DM) + lane;
#pragma unroll
                for (int j = 0; j < 8; ++j) { const unsigned long long w = xr[64 * j]; x[j] = UNPK4(w); } }
            if (ps >= 0) {
                const GAS unsigned long long* yr = (const GAS unsigned long long*)(Y + (size_t)row * DM) + lane;
                const GAS f32x4* ta = (const GAS f32x4*)(T + ((size_t)(ps * BATCH + b) * 3) * DM) + lane;
                f32x4 y[8]; float ss = 0.f;
#pragma unroll
                for (int j = 0; j < 8; ++j) { const unsigned long long w = yr[64 * j]; y[j] = UNPK4(w);
                    ss += (y[j].x * y[j].x + y[j].y * y[j].y) + (y[j].z * y[j].z + y[j].w * y[j].w); }
                const float r = 1.0f / sqrtf(wave_sum(ss) * (1.0f / DM) + EPS);
#pragma unroll
                for (int j = 0; j < 8; ++j) x[j] += ta[64 * j] * (y[j] * r);
            }
            if (ns < 0) {
                GAS f32x4* xo = (GAS f32x4*)(F.out + (size_t)row * DM) + lane;
#pragma unroll
                for (int j = 0; j < 8; ++j) xo[64 * j] = x[j];
            } else {
                GAS unsigned long long* xo = (GAS unsigned long long*)(XB + (size_t)row * DM) + lane;
#pragma unroll
                for (int j = 0; j < 8; ++j) xo[64 * j] = (unsigned long long)pk2(x[j].x, x[j].y) | ((unsigned long long)pk2(x[j].z, x[j].w) << 32);
                float ss = 0.f;
#pragma unroll
                for (int j = 0; j < 8; ++j) ss += (x[j].x * x[j].x + x[j].y * x[j].y) + (x[j].z * x[j].z + x[j].w * x[j].w);
                const float r = 1.0f / sqrtf(wave_sum(ss) * (1.0f / DM) + EPS);
                const GAS f32x4* tb = (const GAS f32x4*)(T + ((size_t)(ns * BATCH + b) * 3 + 1) * DM) + lane;
                const GAS f32x4* tc = (const GAS f32x4*)(T + ((size_t)(ns * BATCH + b) * 3 + 2) * DM) + lane;
                GAS unsigned long long* o8 = (GAS unsigned long long*)(H + (size_t)row * DM) + lane;
#pragma unroll
                for (int j = 0; j < 8; ++j) { const f32x4 h = (x[j] * r) * tb[64 * j] + tc[64 * j];
                    o8[64 * j] = (unsigned long long)pk2(h.x, h.y) | ((unsigned long long)pk2(h.z, h.w) << 32); }
            }
        }
    }
#undef UNPK4
}

struct ThinPre { unsigned long long xw[4][8]; };
__device__ __forceinline__ void thin4_tables(Frame& F, int ps, int ns, int row0) {
    const float* T = (const float*)(F.ws + WS_TAB); const int b = row0 / SEQ;
    int t_ = F.tid; asm volatile("" : "+v"(t_));
    const GAS f32x4* ta = (const GAS f32x4*)(T + ((size_t)(ps * BATCH + b) * 3) * DM) + t_;
    const GAS f32x4* tb = (const GAS f32x4*)(T + ((size_t)((ns < 0 ? 0 : ns) * BATCH + b) * 3 + 1) * DM) + t_;
    LAS f32x4* L = (LAS f32x4*)F.lds + t_;
    L[0] = ta[0]; L[512] = tb[0]; L[1024] = tb[512];
}
__device__ __forceinline__ void thin4_prefetch(Frame& F, int row0, ThinPre& P) {
    int lane_ = F.lane; asm volatile("" : "+v"(lane_));
    const GAS unsigned long long* xr = (const GAS unsigned long long*)((const bf16*)(F.ws + WS_XB) + (size_t)row0 * DM) + lane_;
#pragma unroll
    for (int i = 0; i < 4; ++i)
#pragma unroll
        for (int j = 0; j < 8; ++j) P.xw[i][j] = xr[(size_t)i * (DM / 4) + 64 * j];
}
__device__ __forceinline__ void thin4_rows(Frame& F, int ps, int ns, int row0, const ThinPre& P) {
    const float* T = (const float*)(F.ws + WS_TAB); const bf16* Y = (const bf16*)(F.ws + WS_Y); bf16* H = (bf16*)(F.ws + WS_H); bf16* XB = (bf16*)(F.ws + WS_XB);
    int lane_ = F.lane; asm volatile("" : "+v"(lane_));
    const int lane = lane_, b = row0 / SEQ;
#define UNPK4(w) (f32x4){bf2f((unsigned short)((w) & 0xffffu)), bf2f((unsigned short)(((w) >> 16) & 0xffffu)), bf2f((unsigned short)(((w) >> 32) & 0xffffu)), bf2f((unsigned short)((w) >> 48))}
    const GAS unsigned long long* yr = (const GAS unsigned long long*)(Y + (size_t)row0 * DM) + lane;
    const LAS f32x4* ta = (const LAS f32x4*)F.lds + lane;
    const LAS f32x4* tb = ta + 512; const LAS f32x4* tc = ta + 1024;
    unsigned long long yw[4][8];
#pragma unroll
    for (int i = 0; i < 4; ++i)
#pragma unroll
        for (int j = 0; j < 8; ++j) yw[i][j] = yr[(size_t)i * (DM / 4) + 64 * j];
#pragma unroll
    for (int i = 0; i < 4; ++i) {
        const int row = row0 + i;
        f32x4 x[8], y[8]; float ss = 0.f;
#pragma unroll
        for (int j = 0; j < 8; ++j) { x[j] = UNPK4(P.xw[i][j]); y[j] = UNPK4(yw[i][j]); ss += (y[j].x * y[j].x + y[j].y * y[j].y) + (y[j].z * y[j].z + y[j].w * y[j].w); }
        const float r = 1.0f / sqrtf(wave_sum(ss) * (1.0f / DM) + EPS);
#pragma unroll
        for (int j = 0; j < 8; ++j) x[j] += ta[64 * j] * (y[j] * r);
        if (ns < 0) { GAS f32x4* xo = (GAS f32x4*)(F.out + (size_t)row * DM) + lane;
#pragma unroll
            for (int j = 0; j < 8; ++j) xo[64 * j] = x[j];
        } else {
            GAS unsigned long long* xo = (GAS unsigned long long*)(XB + (size_t)row * DM) + lane;
            float s2 = 0.f;
#pragma unroll
            for (int j = 0; j < 8; ++j) { xo[64 * j] = (unsigned long long)pk2(x[j].x, x[j].y) | ((unsigned long long)pk2(x[j].z, x[j].w) << 32);
                s2 += (x[j].x * x[j].x + x[j].y * x[j].y) + (x[j].z * x[j].z + x[j].w * x[j].w); }
            const float r2 = 1.0f / sqrtf(wave_sum(s2) * (1.0f / DM) + EPS);
            GAS unsigned long long* o8 = (GAS unsigned long long*)(H + (size_t)row * DM) + lane;
#pragma unroll
            for (int j = 0; j < 8; ++j) { const f32x4 h = (x[j] * r2) * tb[64 * j] + tc[64 * j];
                o8[64 * j] = (unsigned long long)pk2(h.x, h.y) | ((unsigned long long)pk2(h.z, h.w) << 32); }
        }
    }
#undef UNPK4
}

namespace att {
constexpr int LDP = HD, LDO = DM;
constexpr float SCALE = 0.08838834764831845f, LOG2E = 1.4426950408889634f, CS = SCALE * LOG2E;
constexpr int TILE_B = 16384, L_V = 0, L_K = 4 * TILE_B;
#define SBAR() __builtin_amdgcn_sched_barrier(0)
__device__ __forceinline__ int crow(int r, int hi) { return (r & 3) + 8 * (r >> 2) + 4 * hi; }
__device__ __forceinline__ unsigned cvtpk(float lo, float hi) { unsigned r; asm volatile("v_cvt_pk_bf16_f32 %0, %1, %2" : "=v"(r) : "v"(lo), "v"(hi)); return r; }
__device__ __forceinline__ int kf(int row) { return (row & 3) | (((row >> 2) & 1) << 2) | (((row >> 5) & 1) << 3); }
__device__ __forceinline__ int kswz(int row, int colB) { return row * 256 + (colB ^ (kf(row) << 4)); }
__device__ __forceinline__ int v_st(int k, int c) { const int kk = (k & ~0xC) | ((k & 4) << 1) | ((k & 8) >> 1); return ((kk >> 3) * 4 + (c >> 5)) * 512 + ((kk & 7) * 32 + (c & 31)) * 2; }
__device__ __forceinline__ int v_sigma(int a) { return 16 * ((a >> 3) & 3) + 8 * (a >> 5) + (a & 7); }
__device__ __forceinline__ int v_rd_base(int lane) { return ((lane & 3) << 3) | (((lane >> 2) & 3) << 6) | (((lane >> 4) & 1) << 5) | (((lane >> 5) & 1) << 8); }
constexpr int v_rd_off(int d0, int ks, int half) { return d0 * 512 + ks * 4096 + half * 2048; }
template <int OFF> __device__ __forceinline__ s16x4 tr_read(int vb) { s16x4 r; asm volatile("ds_read_b64_tr_b16 %0, %1 offset:%2" : "=&v"(r) : "v"(vb), "i"(OFF) : "memory"); return r; }
template <int D0> __device__ __forceinline__ void pv_one(f32x16& od, int vb, bf16x8 pa0, bf16x8 pa1, bf16x8 pa2, bf16x8 pa3) {
    const s16x4 l0 = tr_read<v_rd_off(D0, 0, 0)>(vb), h0 = tr_read<v_rd_off(D0, 0, 1)>(vb), l1 = tr_read<v_rd_off(D0, 1, 0)>(vb), h1 = tr_read<v_rd_off(D0, 1, 1)>(vb);
    const s16x4 l2 = tr_read<v_rd_off(D0, 2, 0)>(vb), h2 = tr_read<v_rd_off(D0, 2, 1)>(vb), l3 = tr_read<v_rd_off(D0, 3, 0)>(vb), h3 = tr_read<v_rd_off(D0, 3, 1)>(vb);
    asm volatile("s_waitcnt lgkmcnt(0)" ::: "memory"); SBAR();
#define PK(L, H) (bf16x8){L[0], L[1], L[2], L[3], H[0], H[1], H[2], H[3]}
    od = __builtin_amdgcn_mfma_f32_32x32x16_bf16(pa0, PK(l0, h0), od, 0, 0, 0);
    od = __builtin_amdgcn_mfma_f32_32x32x16_bf16(pa1, PK(l1, h1), od, 0, 0, 0);
    od = __builtin_amdgcn_mfma_f32_32x32x16_bf16(pa2, PK(l2, h2), od, 0, 0, 0);
    od = __builtin_amdgcn_mfma_f32_32x32x16_bf16(pa3, PK(l3, h3), od, 0, 0, 0);
#undef PK
}
__device__ __forceinline__ void pv_all(f32x16* o, int vb, bf16x8 pa0, bf16x8 pa1, bf16x8 pa2, bf16x8 pa3) {
    pv_one<0>(o[0], vb, pa0, pa1, pa2, pa3); pv_one<1>(o[1], vb, pa0, pa1, pa2, pa3); pv_one<2>(o[2], vb, pa0, pa1, pa2, pa3); pv_one<3>(o[3], vb, pa0, pa1, pa2, pa3);
}
__device__ __forceinline__ float swap_max(float v) { auto rr = __builtin_amdgcn_permlane32_swap(__float_as_uint(v), __float_as_uint(v), false, false); return fmaxf(__uint_as_float(rr[0]), __uint_as_float(rr[1])); }
__device__ __forceinline__ float swap_add(float v) { auto rr = __builtin_amdgcn_permlane32_swap(__float_as_uint(v), __float_as_uint(v), false, false); return __uint_as_float(rr[0]) + __uint_as_float(rr[1]); }
__device__ __forceinline__ float swap_get(float v, int hi) { auto rr = __builtin_amdgcn_permlane32_swap(__float_as_uint(v), __float_as_uint(v), false, false); return hi ? __uint_as_float(rr[0]) : __uint_as_float(rr[1]); }
__device__ __forceinline__ void qkt(f32x16& p0, f32x16& p1, const LAS unsigned char* Kt, const bf16x8 (&qr)[8], int kbase0, int kbase1, int kxc) {
    p0 = (f32x16){}; p1 = (f32x16){};
    bf16x8 fa[2], fb[2];
#define QK_LOAD(F, c) do { const int cb = (32 * (c)) ^ kxc; F[0] = *(const LAS bf16x8*)(Kt + kbase0 + cb); F[1] = *(const LAS bf16x8*)(Kt + kbase1 + cb); } while (0)
#define QK_MMA(F, c) do { p0 = __builtin_amdgcn_mfma_f32_32x32x16_bf16(F[0], qr[c], p0, 0, 0, 0); p1 = __builtin_amdgcn_mfma_f32_32x32x16_bf16(F[1], qr[c], p1, 0, 0, 0); } while (0)
    QK_LOAD(fa, 0); QK_LOAD(fb, 1); SBAR();
    QK_MMA(fa, 0); QK_LOAD(fa, 2); SBAR(); QK_MMA(fb, 1); QK_LOAD(fb, 3); SBAR();
    QK_MMA(fa, 2); QK_LOAD(fa, 4); SBAR(); QK_MMA(fb, 3); QK_LOAD(fb, 5); SBAR();
    QK_MMA(fa, 4); QK_LOAD(fa, 6); SBAR(); QK_MMA(fb, 5); QK_LOAD(fb, 7); SBAR();
    QK_MMA(fa, 6); QK_MMA(fb, 7);
#undef QK_LOAD
#undef QK_MMA
}
__device__ __forceinline__ void pack_p(const f32x16& p0, const f32x16& p1, bf16x8& pa0, bf16x8& pa1, bf16x8& pa2, bf16x8& pa3) {
    v4u w;
    w.x = cvtpk(p0[0], p0[1]); w.y = cvtpk(p0[2], p0[3]); w.z = cvtpk(p0[4], p0[5]); w.w = cvtpk(p0[6], p0[7]); pa0 = __builtin_bit_cast(bf16x8, w);
    w.x = cvtpk(p0[8], p0[9]); w.y = cvtpk(p0[10], p0[11]); w.z = cvtpk(p0[12], p0[13]); w.w = cvtpk(p0[14], p0[15]); pa1 = __builtin_bit_cast(bf16x8, w);
    w.x = cvtpk(p1[0], p1[1]); w.y = cvtpk(p1[2], p1[3]); w.z = cvtpk(p1[4], p1[5]); w.w = cvtpk(p1[6], p1[7]); pa2 = __builtin_bit_cast(bf16x8, w);
    w.x = cvtpk(p1[8], p1[9]); w.y = cvtpk(p1[10], p1[11]); w.z = cvtpk(p1[12], p1[13]); w.w = cvtpk(p1[14], p1[15]); pa3 = __builtin_bit_cast(bf16x8, w);
}
__device__ __forceinline__ void moba_tile(f32x16& p0, f32x16& p1, const LAS float* lut, int dbase, bool sel, bool near, float& m_run, float& l_run, float& alpha,
                                          bf16x8& pa0, bf16x8& pa1, bf16x8& pa2, bf16x8& pa3) {
    const float ninf = -__builtin_inff();
    float ps = 0.f;
    if (near) {
        float pmax = ninf;
#pragma unroll
        for (int r = 0; r < 16; ++r) { const int d0_ = dbase - r, d1_ = dbase - 16 - r;
            const int c0 = d0_ < 0 ? 0 : (d0_ > 128 ? 128 : d0_), c1 = d1_ < 0 ? 0 : (d1_ > 128 ? 128 : d1_);
            float b0 = lut[c0], b1 = lut[c1]; asm volatile("" : "+v"(b0), "+v"(b1));
            p0[r] = (sel && d0_ >= 0) ? fmaf(p0[r], CS, b0) : ninf; p1[r] = (sel && d1_ >= 0) ? fmaf(p1[r], CS, b1) : ninf;
            pmax = fmaxf(pmax, fmaxf(p0[r], p1[r])); }
        pmax = swap_max(pmax);
        if (__all(pmax <= m_run + 11.5f)) alpha = 1.f;
        else { const float mn = fmaxf(m_run, pmax); alpha = __builtin_amdgcn_exp2f(m_run - mn); m_run = mn; }
#pragma unroll
        for (int r = 0; r < 16; ++r) { p0[r] = __builtin_amdgcn_exp2f(p0[r] - m_run); p1[r] = __builtin_amdgcn_exp2f(p1[r] - m_run); ps += p0[r] + p1[r]; }
    } else {
        const float bb = lut[128];
        float smax = fmaxf(p0[0], p1[0]);
#pragma unroll
        for (int r = 1; r < 16; ++r) smax = fmaxf(smax, fmaxf(p0[r], p1[r]));
        float pmax = sel ? fmaf(smax, CS, bb) : ninf;
        pmax = swap_max(pmax);
        if (__all(pmax <= m_run + 11.5f)) alpha = 1.f;
        else { const float mn = fmaxf(m_run, pmax); alpha = __builtin_amdgcn_exp2f(m_run - mn); m_run = mn; }
        const float bm = sel ? bb - m_run : ninf;
#pragma unroll
        for (int r = 0; r < 16; ++r) { p0[r] = __builtin_amdgcn_exp2f(fmaf(p0[r], CS, bm)); p1[r] = __builtin_amdgcn_exp2f(fmaf(p1[r], CS, bm)); ps += p0[r] + p1[r]; }
    }
    ps = swap_add(ps);
    l_run = l_run * alpha + ps;
    pack_p(p0, p1, pa0, pa1, pa2, pa3);
}
template <bool DIAG>
__device__ __forceinline__ void sb_elems(f32x16& P, int dm, int off, float& run) {
#pragma unroll
    for (int r = 15; r >= 0; --r) { const float t = __builtin_amdgcn_exp2f(P[r]); float u = __builtin_amdgcn_rcpf(1.0f + t); float be = 1.0f - u;
        if (DIAG) { const bool ok = dm - off - r > 0; be = ok ? be : 0.f; u = ok ? u : 1.f; }
        P[r] = be * run; run *= u; }
}
__device__ __forceinline__ void sb_finish(f32x16& p0, f32x16& p1, float run, int hi, float& Rp, bf16x8& pa0, bf16x8& pa1, bf16x8& pa2, bf16x8& pa3) {
    const float tp = swap_get(run, hi);
    const float base = Rp * (hi == 0 ? tp : 1.0f);
    Rp *= run * tp;
#pragma unroll
    for (int r = 0; r < 16; ++r) { p0[r] *= base; p1[r] *= base; }
    pack_p(p0, p1, pa0, pa1, pa2, pa3);
}

template <bool MOBA>
__device__ __forceinline__ void attn_unit(LAS unsigned char* lds, const bf16* __restrict__ proj, bf16* __restrict__ Oout, const float* __restrict__ kmean, const float* __restrict__ rel_bias,
                                          const float* __restrict__ out_gain, int b, int hd, int qblk, void* dq_out = nullptr) {
    int tid_ = threadIdx.x; asm volatile("" : "+v"(tid_));
    const int tid = tid_, wid = __builtin_amdgcn_readfirstlane(tid >> 6), lane = tid & 63, r32 = lane & 31, hi = lane >> 5;
    const int qslot = (MOBA ? 0 : 24) + hd, ocol = (MOBA ? 0 : 1024) + hd * HD;
    const size_t rowb = (size_t)b * SEQ, qcol = (size_t)qslot * M * HD, kcol = qcol + (size_t)8 * M * HD, vcol = qcol + (size_t)16 * M * HD;
    LAS unsigned char* V_lds = lds + L_V; LAS unsigned char* K_lds = lds + L_K;
    LAS float* wsc = (LAS float*)(lds + A_WS) + wid * 64;
    LAS float* km = (LAS float*)(lds + A_KM); LAS float* lut = (LAS float*)(lds + A_LUT);
    const int q0w = qblk * 256 + wid * 32, tq = q0w + r32;
    const bool trail = wid >= 4;
    unsigned voffK[2], voffV[2];
#pragma unroll
    for (int j = 0; j < 2; ++j) {
        const int r = 8 * wid + 4 * j + (lane >> 4), cs = (lane & 15) ^ kf(r);
        voffK[j] = (unsigned)(r * LDP + cs * 8) * 2u;
        const int cg = (2 * j + (lane >> 5)) & 3, kq = (lane >> 2) & 7, cc = lane & 3, kk = 8 * wid + kq;
        const int n = (kk & ~0xC) | ((kk & 4) << 1) | ((kk & 8) >> 1), a = (n & 7) | (((n >> 3) & 1) << 5) | (((n >> 4) & 3) << 3);
        voffV[j] = (unsigned)(a * LDP + 32 * cg + 8 * cc) * 2u;
    }
    const char* Kg = (const char*)(proj + rowb * LDP + kcol); const char* Vg = (const char*)(proj + rowb * LDP + vcol);
#define DMA_K(jt, slot) do { const char* kb_ = Kg + (size_t)(jt) * (64 * LDP * 2); \
    _Pragma("unroll") for (int j_ = 0; j_ < 2; ++j_) __builtin_amdgcn_global_load_lds((const unsigned*)(kb_ + voffK[j_]), (LAS unsigned*)(K_lds + (slot) * TILE_B + wid * 2048 + j_ * 1024), 16, 0, 0); } while (0)
#define DMA_V(jt, slot) do { const char* vb_ = Vg + (size_t)(jt) * (64 * LDP * 2); \
    _Pragma("unroll") for (int j_ = 0; j_ < 2; ++j_) __builtin_amdgcn_global_load_lds((const unsigned*)(vb_ + voffV[j_]), (LAS unsigned*)(V_lds + (slot) * TILE_B + wid * 2048 + j_ * 1024), 16, 0, 0); } while (0)
    const int NT = 4 * (qblk + 1);
#if DIAG_Q > 0
    unsigned long long dq_t0 = __builtin_amdgcn_s_memtime(), dq_s1 = 0, dq_s2 = 0, dq_bar = 0, dq_dw = 0, dq_pro = 0, dq_loop = 0; const unsigned long long dq_r0 = __builtin_amdgcn_s_memrealtime();
#define DQ_T() __builtin_amdgcn_s_memtime()
#define DQ_ADD(acc, expr) do { const unsigned long long a_ = DQ_T(); expr; acc += DQ_T() - a_; } while (0)
#else
#define DQ_ADD(acc, expr) do { expr; } while (0)
#endif
    bf16x8 qr[8];
    { const bf16* Qw = proj + (rowb + tq) * LDP + qcol + hi * 8;
#pragma unroll
      for (int d0 = 0; d0 < 8; ++d0) qr[d0] = *(const GAS bf16x8*)(Qw + d0 * 16); }
    DMA_K(NT - 1, 0); DMA_V(NT - 1, 0); DMA_K(NT - 2, 1); DMA_V(NT - 2, 1); DMA_K(NT - 3, 2);
    if constexpr (!MOBA) {
#pragma unroll
        for (int d0 = 0; d0 < 8; ++d0) { v4u w;
            w.x = cvtpk(bf2f((unsigned short)qr[d0][0]) * CS, bf2f((unsigned short)qr[d0][1]) * CS); w.y = cvtpk(bf2f((unsigned short)qr[d0][2]) * CS, bf2f((unsigned short)qr[d0][3]) * CS);
            w.z = cvtpk(bf2f((unsigned short)qr[d0][4]) * CS, bf2f((unsigned short)qr[d0][5]) * CS); w.w = cvtpk(bf2f((unsigned short)qr[d0][6]) * CS, bf2f((unsigned short)qr[d0][7]) * CS);
            qr[d0] = __builtin_bit_cast(bf16x8, w); } }
    unsigned selmask = 0u;
    if constexpr (MOBA) {
        for (int i = tid; i < 1024; i += NWAVES * 64) km[i] = kmean[(size_t)((b * 8 + hd) * 8) * 128 + i];
        if (tid < 129) { const int n = tid; int bk = n;
            if (n >= 16) { bk = 16 + (int)(logf((float)n / 16.0f) / logf(8.0f) * 16.0f); bk = bk > 31 ? 31 : bk; }
            lut[tid] = rel_bias[bk * 8 + hd] * LOG2E; }
        __syncthreads();
        float gv[7];
#pragma unroll
        for (int n = 0; n < 7; ++n) { float a = 0.f;
            if (n < qblk) {
#pragma unroll
                for (int d0 = 0; d0 < 8; ++d0) { const LAS f32x4* kp = (const LAS f32x4*)(km + n * 128 + d0 * 16 + hi * 8); const f32x4 k0v = kp[0], k1v = kp[1];
                    a += bf2f((unsigned short)qr[d0][0]) * k0v[0] + bf2f((unsigned short)qr[d0][1]) * k0v[1] + bf2f((unsigned short)qr[d0][2]) * k0v[2] + bf2f((unsigned short)qr[d0][3]) * k0v[3]
                       + bf2f((unsigned short)qr[d0][4]) * k1v[0] + bf2f((unsigned short)qr[d0][5]) * k1v[1] + bf2f((unsigned short)qr[d0][6]) * k1v[2] + bf2f((unsigned short)qr[d0][7]) * k1v[3]; }
                a = swap_add(a); }
            gv[n] = a; }
        const int nsel = qblk < 3 ? qblk : 3;
#pragma unroll
        for (int t = 0; t < 3; ++t) { if (t < nsel) { float best = -__builtin_inff(); unsigned bi = 0u;
#pragma unroll
            for (int n = 0; n < 7; ++n) { const bool ok = (n < qblk) && !((selmask >> n) & 1u) && (gv[n] > best); best = ok ? gv[n] : best; bi = ok ? (unsigned)n : bi; }
            selmask |= 1u << bi; } }
        selmask |= 1u << qblk;
    }
    const int kr0 = 32 * ((r32 >> 2) & 1) + (r32 & 3) + 4 * (r32 >> 3);
    const int kbase0 = kr0 * 256, kbase1 = (kr0 + 16) * 256, kxc = (16 * hi) ^ (kf(kr0) << 4);
    const int vb0 = (int)(unsigned)(uintptr_t)V_lds + v_rd_base(lane);
#define RESC(a) do { if (__any((a) < 1.f)) { if (hi == 0) wsc[r32] = (a); LDS_WAIT(); \
    _Pragma("unroll") for (int r = 0; r < 16; ++r) { const float al_ = wsc[crow(r, hi)]; _Pragma("unroll") for (int d = 0; d < 4; ++d) o[d][r] *= al_; } } } while (0)
#define T_DBASE(jt) (tq - (64 * (jt) + 32 * hi))
#define T_DIAG(jt) (((jt) >> 2) == qblk)
#define T_SEL(jt) (((selmask >> ((jt) >> 2)) & 1u) != 0u)
#define T_NEAR(jt) ((q0w - (64 * (jt) + 63)) < 128)
#define T_ACT(jt) (!T_DIAG(jt) || (64 * ((jt) & 3) <= wid * 32 + (MOBA ? 31 : 30)))
#define BAR() do { asm volatile("" ::: "memory"); __builtin_amdgcn_s_barrier(); asm volatile("" ::: "memory"); } while (0)
    f32x16 o[4];
#pragma unroll
    for (int d = 0; d < 4; ++d) o[d] = (f32x16){};
    float m_run = -1e30f, l_run = 0.f, R = 1.f, al = 1.f, bs = 1.f;
    f32x16 p0, p1; bf16x8 pa0, pa1, pa2, pa3;
#define ST_VALU(jt) do { if (T_ACT(jt)) { \
        if constexpr (MOBA) { moba_tile(p0, p1, lut, T_DBASE(jt), T_SEL(jt), T_NEAR(jt), m_run, l_run, al, pa0, pa1, pa2, pa3); RESC(al); } \
        else { bs = 1.0f; if (T_DIAG(jt)) { sb_elems<true>(p1, T_DBASE(jt), 16, bs); sb_elems<true>(p0, T_DBASE(jt), 0, bs); } else { sb_elems<false>(p1, 0, 0, bs); sb_elems<false>(p0, 0, 0, bs); } \
               sb_finish(p0, p1, bs, hi, R, pa0, pa1, pa2, pa3); } } } while (0)
#define ST_MFMA(jt, sl, more) do { if (T_ACT(jt)) pv_all(o, vb0 + (sl) * TILE_B, pa0, pa1, pa2, pa3); \
        if ((more) && T_ACT((jt) - 1)) qkt(p0, p1, K_lds + (((sl) + 1) & 3) * TILE_B, qr, kbase0, kbase1, kxc); } while (0)
    asm volatile("s_waitcnt vmcnt(4)" ::: "memory");
    BAR();
    qkt(p0, p1, K_lds, qr, kbase0, kbase1, kxc);
#if DIAG_Q > 0
    dq_pro = DQ_T() - dq_t0; const unsigned long long dq_l0 = DQ_T();
#endif
    volatile LAS unsigned* dflag = (volatile LAS unsigned*)(lds + A_WS);
    bool broke = false; int dq_iters = 0;
    for (int j = 0; j < NT; ++j) { ++dq_iters;
        const int jt = NT - 1 - j;
        const bool mk = j + 3 < NT, mv = j + 2 < NT;
        if (mk) DMA_K(jt - 3, (j + 3) & 3);
        if (mv) DMA_V(jt - 2, (j + 2) & 3);
        if constexpr (!MOBA) { const bool dead = __all(R == 0.f) != 0; if (lane == 0) dflag[(j & 1) * 8 + wid] = dead ? 1u : 0u; }
        if (trail && j > 0) DQ_ADD(dq_s2, ST_MFMA(jt + 1, (j - 1) & 3, true));
        DQ_ADD(dq_s1, ST_VALU(jt));
        if (!trail) DQ_ADD(dq_s2, ST_MFMA(jt, j & 3, j + 1 < NT));
        if (mk) asm volatile("s_waitcnt vmcnt(4)" ::: "memory"); else if (mv) asm volatile("s_waitcnt vmcnt(2)" ::: "memory"); else asm volatile("s_waitcnt vmcnt(0)" ::: "memory");
        if constexpr (!MOBA) LDS_WAIT();
        DQ_ADD(dq_bar, BAR());
        if constexpr (!MOBA) { unsigned all = 1u;
#pragma unroll
            for (int w = 0; w < 8; ++w) all &= dflag[(j & 1) * 8 + w];
            if (__builtin_amdgcn_readfirstlane(all) != 0u) { broke = true; break; } }
    }
    if (trail && !broke) ST_MFMA(0, (NT - 1) & 3, false);
    asm volatile("s_waitcnt vmcnt(0)" ::: "memory");
    BAR();
#if DIAG_Q > 0
    dq_loop = DQ_T() - dq_l0;
#endif
#undef ST_VALU
#undef ST_MFMA
#undef DMA_K
#undef DMA_V
#undef RESC
    float rl[16];
    if constexpr (MOBA) { if (hi == 0) wsc[32 + r32] = l_run; LDS_WAIT();
#pragma unroll
        for (int r = 0; r < 16; ++r) rl[r] = 1.0f / wsc[32 + crow(r, hi)];
    } else {
#pragma unroll
        for (int r = 0; r < 16; ++r) rl[r] = 1.0f;
    }
    float gn[4];
#pragma unroll
    for (int d = 0; d < 4; ++d) gn[d] = out_gain[ocol + 32 * d + r32];
    LAS unsigned char* ost = lds + wid * 8192;
#pragma unroll
    for (int r = 0; r < 16; ++r) {
        float v[4]; float ss = 0.f;
#pragma unroll
        for (int d = 0; d < 4; ++d) { v[d] = o[d][r] * rl[r]; ss += v[d] * v[d]; }
        {
#define AT_DPP(x, ctrl) __builtin_bit_cast(float, __builtin_amdgcn_update_dpp(0, __builtin_bit_cast(int, (x)), (ctrl), 0xf, 0xf, true))
            ss += AT_DPP(ss, 0x111); ss += AT_DPP(ss, 0x112); ss += AT_DPP(ss, 0x114); ss += AT_DPP(ss, 0x118);
#undef AT_DPP
            const float t0 = __builtin_bit_cast(float, __builtin_amdgcn_readlane(__builtin_bit_cast(int, ss), 15)), t1 = __builtin_bit_cast(float, __builtin_amdgcn_readlane(__builtin_bit_cast(int, ss), 31));
            const float t2 = __builtin_bit_cast(float, __builtin_amdgcn_readlane(__builtin_bit_cast(int, ss), 47)), t3 = __builtin_bit_cast(float, __builtin_amdgcn_readlane(__builtin_bit_cast(int, ss), 63));
            ss = hi ? (t2 + t3) : (t0 + t1); }
        const float rs = 1.0f / sqrtf(ss * (1.0f / HD) + EPS);
#pragma unroll
        for (int d = 0; d < 4; ++d) *(LAS unsigned short*)(ost + crow(r, hi) * 256 + (32 * d + r32) * 2) = (unsigned short)f2bf(v[d] * rs * gn[d]);
    }
    LDS_WAIT(); asm volatile("" ::: "memory");
    { bf16* Ob = Oout + (rowb + q0w) * LDO + ocol;
#pragma unroll
      for (int i = 0; i < 8; ++i) { const int row = (lane >> 4) + 4 * i, ch = lane & 15;
        const v4u w = *(const LAS v4u*)(ost + row * 256 + ch * 16);
        *(GAS v4u*)(Ob + (size_t)row * LDO + ch * 8) = w; } }
    LDS_WAIT(); asm volatile("" ::: "memory");
    __syncthreads();
#if DIAG_Q > 0
    if (blockIdx.x == DIAG_BX && wid == DIAG_W && lane == 0 && (MOBA ? !DIAG_SB : DIAG_SB)) {
        const unsigned long long tot = DQ_T() - dq_t0, rt = __builtin_amdgcn_s_memrealtime() - dq_r0;
        const unsigned long long v = DIAG_Q == 1 ? tot : DIAG_Q == 2 ? dq_s1 : DIAG_Q == 3 ? dq_s2 : DIAG_Q == 4 ? dq_bar : DIAG_Q == 5 ? dq_dw : DIAG_Q == 6 ? dq_pro : DIAG_Q == 7 ? dq_loop : rt;
        ((float*)dq_out)[0] = DIAG_Q == 10 ? 16.0f * (float)dq_iters : DIAG_Q == 11 ? 16.0f * (R == 0.f ? 100.f : (R < 1e-30f ? 10.f : 1.f)) : (DIAG_Q >= 2 && DIAG_Q <= 5) ? (float)v / (float)NT : (float)v; }
#endif
#undef BAR
}
}

struct Args { const float* in[16]; float* out; unsigned char* ws; int ph_lo, ph_hi; };
constexpr int N_PHASES = 3 + DEPTH * 3 * 5;

__global__ void __launch_bounds__(NWAVES * 64, 2) fwd(Args args) {
    extern __shared__ __attribute__((aligned(16))) unsigned char lds_raw[];
    Frame F;
    F.lds = (LAS unsigned char*)lds_raw;
    F.tid = threadIdx.x; F.lane = F.tid & 63; F.wave = __builtin_amdgcn_readfirstlane(F.tid >> 6);
    F.G = gridDim.x; F.gw = blockIdx.x * NWAVES + F.wave; F.NGW = F.G * NWAVES;
    F.inp = (const __attribute__((address_space(4))) unsigned long long*)__builtin_amdgcn_kernarg_segment_ptr();
    F.out = args.out; F.ws = args.ws;
    volatile LAS unsigned* MISC = (volatile LAS unsigned*)(F.lds + LDSCTL_OFF);
    if (F.tid < 64) MISC[F.tid] = 0u;
    __syncthreads();
    const int lo = args.ph_lo, hi = args.ph_hi;
    const bool multi = (hi - lo) > 1;
    XcdBarrier bar; bar.bar = (unsigned*)(F.ws + WS_CTL) + CW_BAR; bar.x = 0; bar.st = MISC;
    if (multi) bar = xcd_barrier_post((unsigned*)(F.ws + WS_CTL) + CW_BAR, MISC);
#define IN(k) (lo <= (k) && (k) < hi)
#define SEAM(k) do { if (IN((k) + 1)) xcd_barrier(bar); } while (0)

#ifndef DIS_P0
    if (IN(0)) { for (int rep = 0; rep < REP_P0; ++rep) { p0_prologue(F); __syncthreads(); } SEAM(0); }
#endif
#ifndef DIS_THIN
    if (IN(1)) { p0_mod_tables(F); SEAM(1); }
    if (IN(2)) { thin_phase(F, -1, 0, -1); SEAM(2); }
#endif

    bf16* Hb = (bf16*)(F.ws + WS_H); bf16* HID = (bf16*)(F.ws + WS_HID); bf16* PROJ = (bf16*)(F.ws + WS_PROJ); bf16* Ob = (bf16*)(F.ws + WS_O); bf16* Yb = (bf16*)(F.ws + WS_Y);
    for (int l = 0; l < DEPTH; ++l) {
        unsigned char* wl = F.ws + WS_W + (size_t)l * W_LAYER;
        for (int s = 0; s < 3; ++s) {
            const int pb = 3 + (l * 3 + s) * 5;
            const bool probe_att = (l == DEPTH - 1 && s == 1 && lo > N_PHASES);
            if ((pb + 5 <= lo || pb >= hi) && !probe_att) continue;
            if (s != 1) {
                if (IN(pb)) {
                    const bool hide = (F.G == 256) && (HIDE_N > 0);
                    const int Gg = hide ? F.G - HIDE_WGS : F.G, hk = 2 * l + (s >> 1);
                    int hst = 0, hln = 0;
#pragma unroll
                    for (int k = 0; k < 2 * DEPTH; ++k) if (k == hk) { hst = hide_start(k); hln = hide_len(k); }
                    unsigned* cq = (unsigned*)(F.ws + 2048) + (size_t)hk * 64;
                    if ((int)blockIdx.x < Gg) {
                        pg8::Gemm g{Hb, (const bf16*)(wl + (s == 0 ? W_GU1 : W_GU2)), M, 2 * DFF, DM, DM, DM}; pg8::StaticOrder S; S.init(M, 2 * DFF, Gg, (int)blockIdx.x);
                        pg8::EpiSwiGLU E{HID, LDH};
                        for (int rep = 0; rep < REP_UP; ++rep) pg8::gemm_phase<pg8::EpiSwiGLU, pg8::StaticOrder, true>(F.lds, g, S, E);
                        if (hide) convert_dynamic<false>(F, hst, hln, cq);
                    } else convert_dynamic<true>(F, hst, hln, cq);
                    if (IN(pb + 3)) xcd_barrier(bar);
                }
            } else {
                if (IN(pb)) {
                    pg8::Gemm g{Hb, (const bf16*)(wl + W_IN), M, DIN, DM, DM, DM}; pg8::StaticOrder S; S.init(M, DIN, F.G, (int)blockIdx.x);
                    pg8::EpiProj E{PROJ, M, (float*)(F.ws + WS_KMEAN) + (size_t)l * (BATCH * 8 * 8 * 128)};
                    for (int rep = 0; rep < REP_INP; ++rep) pg8::gemm_phase<pg8::EpiProj, pg8::StaticOrder, true>(F.lds, g, S, E);
                    if (IN(pb + 2)) xcd_barrier(bar);
                }
                if (IN(pb + 2) || probe_att) {
                    const bool do_moba = !probe_att || lo == N_PHASES + 1, do_sb = !probe_att || lo == N_PHASES + 2;
                    const float* KM = (const float*)(F.ws + WS_KMEAN) + (size_t)l * (BATCH * 8 * 8 * 128); const float* gain = F.in(10) + (size_t)l * DM;
                    for (int rep = 0; rep < REP_ATT; ++rep) {
                    const int vcu0 = (F.G % 8 == 0) ? (int)(blockIdx.x % 8) * (F.G / 8) + (int)(blockIdx.x / 8) : (int)blockIdx.x;
                    {
                        unsigned* qctr = (unsigned*)(F.ws + 1024) + (size_t)l * 64;
                        volatile LAS unsigned* qslot = (volatile LAS unsigned*)(F.lds + LDSCTL_OFF) + 4;
                        for (;;) {
                            if (F.tid == 0) qslot[0] = __hip_atomic_fetch_add(qctr, 1u, __ATOMIC_RELAXED, __HIP_MEMORY_SCOPE_AGENT);
                            __syncthreads();
                            const unsigned idx = qslot[0];
                            if (idx >= 512u) break;
                            const int qb = 7 - (int)(idx >> 6), ty = (int)(idx >> 5) & 1, g = (int)idx & 31, b = g >> 3, hd = g & 7;
                            if (ty == 0) { if (do_moba) {
#ifndef DIS_MOBA
                                att::attn_unit<true>(F.lds, PROJ, Ob, KM, F.in(12), gain, b, hd, qb, F.ws + 64);
#endif
                            } else __syncthreads(); }
                            else { if (do_sb) {
#ifndef DIS_SB
                                att::attn_unit<false>(F.lds, PROJ, Ob, KM, F.in(12), gain, b, hd, qb, F.ws + 64);
#endif
                            } else __syncthreads(); }
                        }
                    }
                    }
                    SEAM(pb + 2);
                }
            }
            const int ps = l * 3 + s, ns = (ps + 1 < DEPTH * 3) ? ps + 1 : -1;
            const bool fuse = (F.G == 256) && IN(pb + 3) && IN(pb + 4);
            if (IN(pb + 3)) {
                const bf16* A = s == 1 ? Ob : HID; const int K = s == 1 ? DM : DFF;
                const bf16* Bt = (const bf16*)(wl + (s == 0 ? W_D1 : (s == 1 ? W_OUT : W_D2)));
                pg8::Gemm g{A, Bt, M, DM, K, s == 1 ? DM : LDH, K}; pg8::StaticOrder S; S.init(M, DM, F.G, (int)blockIdx.x);
                if (fuse) {
                    pg8::EpiBf16<true> E{Yb, DM};
                    pg8::gemm_phase<pg8::EpiBf16<true>, pg8::StaticOrder, false>(F.lds, g, S, E);
                    pg8::Unit u; S.next(0, u);
                    const int trow0 = u.pm * 256 + u.pn * 32 + F.wave * 4;
                    thin4_tables(F, ps, ns, trow0);
                    ThinPre tp; thin4_prefetch(F, trow0, tp);
                    gu32* cnt = (gu32*)(F.ws + WS_PCNT) + (size_t)(ps * 32 + u.pm) * 64;
                    asm volatile("s_waitcnt vmcnt(0)" ::: "memory");
                    if (F.lane == 0) __hip_atomic_fetch_add(cnt, 1u, __ATOMIC_RELAXED, __HIP_MEMORY_SCOPE_AGENT);
                    if (F.wave == 0) {
                        unsigned sp = 0;
                        while ((unsigned)__builtin_amdgcn_readfirstlane(__hip_atomic_load(cnt, __ATOMIC_RELAXED, __HIP_MEMORY_SCOPE_AGENT)) < 64u) {
                            __builtin_amdgcn_s_sleep(1);
                            if (++sp > (1u << 22)) { if (F.lane == 0) atomicAdd(bar.bar + XB_TMO, 1u); break; } }
                        __builtin_amdgcn_fence(__ATOMIC_ACQUIRE, "agent");
                        asm volatile("s_waitcnt vmcnt(0)" ::: "memory");
                    }
                    __syncthreads();
                    thin4_rows(F, ps, ns, trow0, tp);
                    if (ns >= 0) { if (IN(pb + 5)) xcd_barrier(bar); }
                } else {
                    pg8::EpiBf16<false> E{Yb, DM};
                    for (int rep = 0; rep < REP_DOWN; ++rep) pg8::gemm_phase<pg8::EpiBf16<false>, pg8::StaticOrder, false>(F.lds, g, S, E);
                    SEAM(pb + 3);
                }
            }
            if (IN(pb + 4) && !fuse) {
#ifndef DIS_THIN
                thin_phase(F, ps, ns, -1);
#endif
                if (ns >= 0) { if (IN(pb + 5)) xcd_barrier(bar); }
            }
        }
    }
#if DIAG_Q > 0
    if (blockIdx.x == 0 && F.tid == 0 && hi >= N_PHASES) { asm volatile("s_waitcnt vmcnt(0)" ::: "memory"); const float v_ = __hip_atomic_load((float*)(F.ws + 64), __ATOMIC_RELAXED, __HIP_MEMORY_SCOPE_AGENT) * (1.0f / 16.0f); F.out[0] = exp2f(rintf(log2f(v_) * 4.0f) * 0.25f); }
#endif
#undef IN
#undef SEAM
}

extern "C" void kernel_launch(void* const* d_in, const int* in_sizes, int n_in, void* d_out, int out_size, void* d_ws, size_t ws_size, hipStream_t stream) {
    static int grid = 0;
    if (grid == 0) {
        if (n_in != 16 || in_sizes[0] != M * DM || out_size != M * DM || ws_size < WS_END) { fprintf(stderr, "kernel_launch: unexpected shapes (n_in %d, in0 %d, out %d, ws %zu; need ws >= %zu)\n", n_in, n_in > 0 ? in_sizes[0] : -1, out_size, ws_size, (size_t)WS_END); grid = -1; return; }
        int dev = 0, cus = 0, per_cu = 0;
        if (hipGetDevice(&dev) != hipSuccess || hipDeviceGetAttribute(&cus, hipDeviceAttributeMultiprocessorCount, dev) != hipSuccess) { grid = -1; return; }
        if (hipFuncSetAttribute((const void*)fwd, hipFuncAttributeMaxDynamicSharedMemorySize, LDS_BYTES) != hipSuccess) { fprintf(stderr, "kernel_launch: hipFuncSetAttribute failed\n"); grid = -1; return; }
        if (hipOccupancyMaxActiveBlocksPerMultiprocessor(&per_cu, (const void*)fwd, NWAVES * 64, LDS_BYTES) != hipSuccess || per_cu < 1) fprintf(stderr, "kernel_launch: occupancy query reports %d blocks per CU\n", per_cu);
        (void)hipGetLastError();
        grid = cus;
    }
    if (grid < 0) return;
    if (hipMemsetAsync((char*)d_ws + WS_CTL, 0, CTL_ZERO_BYTES, stream) != hipSuccess) return;
    Args a{};
    for (int i = 0; i < 16; ++i) a.in[i] = (const float*)d_in[i];
    a.out = (float*)d_out; a.ws = (unsigned char*)d_ws;
#if MK_PER_PHASE
    for (int p = 0; p < N_PHASES; ++p) {
        if (p >= 3) { const int r = (p - 3) % 5, s = ((p - 3) / 5) % 3; if ((s != 1 && (r == 1 || r == 2)) || (s == 1 && r == 1)) continue; }
        a.ph_lo = p; a.ph_hi = p + 1;
        hipLaunchKernelGGL(fwd, dim3(grid), dim3(NWAVES * 64), LDS_BYTES, stream, a);
    }
#else
    a.ph_lo = 0; a.ph_hi = N_PHASES;
    hipLaunchKernelGGL(fwd, dim3(grid), dim3(NWAVES * 64), LDS_BYTES, stream, a);
    if (PROBE_PH >= 0) for (int r = 0; r < PROBE_REPS; ++r) { a.ph_lo = PROBE_PH; a.ph_hi = PROBE_PH + 1; hipLaunchKernelGGL(fwd, dim3(grid), dim3(NWAVES * 64), LDS_BYTES, stream, a); }
#endif
    const hipError_t le = hipPeekAtLastError();
    if (le != hipSuccess) fprintf(stderr, "kernel_launch: launch failed: %s\n", hipGetErrorName(le));
}
```

```cpp
#include <hip/hip_runtime.h>
#include <cstdio>
#include <cstdint>

#ifndef REP_P0
#define REP_P0 1
#endif
#ifndef REP_UP
#define REP_UP 1
#endif
#ifndef REP_DOWN
#define REP_DOWN 1
#endif
#ifndef REP_INP
#define REP_INP 1
#endif
#ifndef REP_ATT
#define REP_ATT 1
#endif
#ifndef ATT_PRIO
#define ATT_PRIO 1
#endif
#ifndef PROBE_PH
#define PROBE_PH -1
#endif
#ifndef PROBE_REPS
#define PROBE_REPS 4
#endif
#ifndef DIAG_Q
#define DIAG_Q 0
#endif
#ifndef DIAG_W
#define DIAG_W 0
#endif
#ifndef DIAG_BX
#define DIAG_BX 0
#endif
#ifndef DIAG_SB
#define DIAG_SB 0
#endif
#ifndef MK_PER_PHASE
#define MK_PER_PHASE 0
#endif

namespace pg8 {
#define PG8_LAS __attribute__((address_space(3)))
typedef unsigned short bf16_t;
typedef short bf16x8 __attribute__((ext_vector_type(8)));
typedef float f32x4 __attribute__((ext_vector_type(4)));
typedef unsigned u32x4 __attribute__((ext_vector_type(4)));
constexpr int BM = 256, BK = 64, HALF = 128, HTB = HALF * BK * 2, STAGE_BYTES = 8 * HTB, NXCD = 8, WGM = 8;

__host__ __device__ __forceinline__ int lds_byte(int r, int c) { const int st = (r >> 4) * 2 + (c >> 5), rr = r & 15, cc = c & 31, ob = rr * 64 + cc * 2; return st * 1024 + (ob ^ (((ob >> 9) & 1) << 5)); }
__host__ __device__ __forceinline__ void stage_rc(int b, int& R, int& C) { const int st = b / 1024, sb = b % 1024, swz = sb ^ (((sb >> 9) & 1) << 5); R = (st >> 1) * 16 + swz / 64; C = (st & 1) * 32 + (swz % 64) / 2; }
__host__ __device__ __forceinline__ int perm32(int rho) { const int n = rho >> 4, i = rho & 15; return 8 * (i >> 2) + 4 * n + (i & 3); }

struct Unit { int pm, pn; };
struct Gemm { const bf16_t* A; const bf16_t* Bt; int M, N, K, lda, ldb; };

struct StaticOrder {
    int nM, nN, nwg, G, c;
    __host__ __device__ void init(int M, int N, int G_, int c_) { nM = M / BM; nN = N / BM; nwg = nM * nN; G = G_; c = c_; }
    __host__ __device__ bool next(int i, Unit& u) const {
        const long L = (long)i * G + c; if (L >= nwg) return false;
        int wgid = (int)L; { const int q = nwg / NXCD, r = nwg % NXCD, xcd = wgid % NXCD, off = wgid / NXCD; wgid = (xcd < r ? xcd * (q + 1) : r * (q + 1) + (xcd - r) * q) + off; }
        const int nig = WGM * nN, gid = wgid / nig, fm = gid * WGM, gsz = (nM - fm) < WGM ? (nM - fm) : WGM;
        u.pm = fm + ((wgid % nig) % gsz); u.pn = (wgid % nig) / gsz; return true;
    }
    __device__ __forceinline__ void a_ready(const Unit&) const {}
    __device__ __forceinline__ void done(const Unit&) const {}
};

__device__ __forceinline__ unsigned cvt_pk_bf16(float lo, float hi) { unsigned r; asm volatile("v_cvt_pk_bf16_f32 %0, %1, %2" : "=v"(r) : "v"(lo), "v"(hi)); return r; }

struct EpiF32 {
    static constexpr bool PERM = false, AFTER_DRAIN = false;
    float* C; int ldc;
    __device__ __forceinline__ void operator()(const f32x4 (&acc)[2][2][4][2], const Unit& u, int wr, int wc, int fr, int fq) const {
        const int row0 = u.pm * BM + wr * 64 + fr, col0 = u.pn * BM + wc * 32 + 4 * fq;
#pragma unroll
        for (int ai = 0; ai < 2; ++ai)
#pragma unroll
            for (int m = 0; m < 4; ++m) { float* rowp = C + (size_t)(row0 + ai * HALF + m * 16) * ldc + col0;
#pragma unroll
                for (int bj = 0; bj < 2; ++bj)
#pragma unroll
                    for (int n = 0; n < 2; ++n) *(f32x4*)(rowp + bj * HALF + n * 16) = acc[ai][bj][m][n]; }
    }
};
template <bool WT>
struct EpiBf16 {
    static constexpr bool PERM = true, AFTER_DRAIN = false;
    bf16_t* O; int ldc;
    __device__ __forceinline__ void operator()(const f32x4 (&acc)[2][2][4][2], const Unit& u, int wr, int wc, int fr, int fq) const {
        const int row0 = u.pm * BM + wr * 64 + fr, col0 = u.pn * BM + wc * 32 + 8 * fq;
        __amdgpu_buffer_rsrc_t rsrc;
        if constexpr (WT) rsrc = __builtin_amdgcn_make_buffer_rsrc((void*)O, 0, 0x7fffffff, 0x00020000);
#pragma unroll
        for (int ai = 0; ai < 2; ++ai)
#pragma unroll
            for (int m = 0; m < 4; ++m) { const size_t eoff = (size_t)(row0 + ai * HALF + m * 16) * ldc + col0; bf16_t* rowp = O + eoff;
#pragma unroll
                for (int bj = 0; bj < 2; ++bj) { const f32x4 v0 = acc[ai][bj][m][0], v1 = acc[ai][bj][m][1];
                    u32x4 w; w.x = cvt_pk_bf16(v0[0], v0[1]); w.y = cvt_pk_bf16(v0[2], v0[3]); w.z = cvt_pk_bf16(v1[0], v1[1]); w.w = cvt_pk_bf16(v1[2], v1[3]);
                    if constexpr (WT) __builtin_amdgcn_raw_buffer_store_b128(w, rsrc, (int)((eoff + bj * HALF) * 2), 0, 16);
                    else *(u32x4*)(rowp + bj * HALF) = w; } }
    }
};
struct EpiProj {
    static constexpr bool PERM = true, AFTER_DRAIN = false;
    bf16_t* O; int ldc; float* KM;
    __device__ __forceinline__ void operator()(const f32x4 (&acc)[2][2][4][2], const Unit& u, int wr, int wc, int fr, int fq) const {
        const int row0 = u.pm * BM + wr * 64 + fr, colh = wc * 32 + 8 * fq;
#pragma unroll
        for (int ai = 0; ai < 2; ++ai)
#pragma unroll
            for (int m = 0; m < 4; ++m) { bf16_t* rowp = O + ((size_t)(2 * u.pn) * ldc + (size_t)(row0 + ai * HALF + m * 16)) * 128 + colh;
#pragma unroll
                for (int bj = 0; bj < 2; ++bj) { const f32x4 v0 = acc[ai][bj][m][0], v1 = acc[ai][bj][m][1];
                    u32x4 w; w.x = cvt_pk_bf16(v0[0], v0[1]); w.y = cvt_pk_bf16(v0[2], v0[3]); w.z = cvt_pk_bf16(v1[0], v1[1]); w.w = cvt_pk_bf16(v1[2], v1[3]);
                    *(u32x4*)(rowp + (size_t)bj * ldc * 128) = w; } }
        if (u.pn >= 4 && u.pn < 8) {
#pragma unroll
            for (int bj = 0; bj < 2; ++bj)
#pragma unroll
                for (int n = 0; n < 2; ++n) {
                    f32x4 sm = (acc[0][bj][0][n] + acc[0][bj][1][n]) + (acc[0][bj][2][n] + acc[0][bj][3][n]) + (acc[1][bj][0][n] + acc[1][bj][1][n]) + (acc[1][bj][2][n] + acc[1][bj][3][n]);
#pragma unroll
#define PG8_DPP(x, ctrl) __builtin_bit_cast(float, __builtin_amdgcn_update_dpp(0, __builtin_bit_cast(int, (x)), (ctrl), 0xf, 0xf, true))
                    for (int i = 0; i < 4; ++i) { float v = sm[i]; v += PG8_DPP(v, 0x111); v += PG8_DPP(v, 0x112); v += PG8_DPP(v, 0x114); v += PG8_DPP(v, 0x118); sm[i] = v; }
#undef PG8_DPP
                    if (fr == 15) { const int ca = (u.pn - 4) * BM + bj * HALF + wc * 32 + 8 * fq + 4 * n;
                        float* dst = KM + ((size_t)(((u.pm >> 3) * 8 + (ca >> 7)) * 8 + (u.pm & 7))) * 128 + (ca & 127);
#pragma unroll
                        for (int i = 0; i < 4; ++i) atomicAdd(dst + i, sm[i] * (1.0f / 256.0f)); }
                }
        }
    }
};
struct EpiSwiGLU {
    static constexpr bool PERM = true, AFTER_DRAIN = false;
    bf16_t* O; int ldc;
    static __device__ __forceinline__ float swi(float g, float u) { const float e = __builtin_amdgcn_exp2f(-1.4426950408889634f * g); return g * __builtin_amdgcn_rcpf(1.0f + e) * u; }
    __device__ __forceinline__ void operator()(const f32x4 (&acc)[2][2][4][2], const Unit& u, int wr, int wc, int fr, int fq) const {
        const int row0 = u.pm * BM + wr * 64 + fr, col0 = u.pn * HALF + wc * 32 + 8 * fq;
#pragma unroll
        for (int ai = 0; ai < 2; ++ai)
#pragma unroll
            for (int m = 0; m < 4; ++m) { bf16_t* rowp = O + (size_t)(row0 + ai * HALF + m * 16) * ldc + col0;
                const f32x4 g0 = acc[ai][0][m][0], g1 = acc[ai][0][m][1], u0 = acc[ai][1][m][0], u1 = acc[ai][1][m][1];
                u32x4 w; w.x = cvt_pk_bf16(swi(g0[0], u0[0]), swi(g0[1], u0[1])); w.y = cvt_pk_bf16(swi(g0[2], u0[2]), swi(g0[3], u0[3]));
                w.z = cvt_pk_bf16(swi(g1[0], u1[0]), swi(g1[1], u1[1])); w.w = cvt_pk_bf16(swi(g1[2], u1[2]), swi(g1[3], u1[3]));
                *(u32x4*)rowp = w; }
    }
};

template <class Epi, class Sched, bool ALIGN_EPI = false>
__device__ __forceinline__ void gemm_phase(PG8_LAS unsigned char* lds, const Gemm g, const Sched& S, const Epi& E) {
    int tid_ = threadIdx.x; asm volatile("" : "+v"(tid_));
    const int tid = tid_, wid = __builtin_amdgcn_readfirstlane(tid >> 6), lane = tid & 63, wr = wid >> 2, wc = wid & 3, fr = lane & 15, fq = lane >> 4;
    const int K = g.K, nt = K / BK;
    unsigned voffA[2], voffB[2];
#pragma unroll
    for (int i = 0; i < 2; ++i) { int R, C; stage_rc(tid * 16 + i * 8192, R, C); const int Rb = Epi::PERM ? ((R & ~31) + perm32(R & 31)) : R;
        voffA[i] = (unsigned)(R * g.lda + C) * 2u; voffB[i] = (unsigned)(Rb * g.ldb + C) * 2u; }
    const size_t kstep = (size_t)(BK * 2);
    const size_t hstepA = (size_t)HALF * g.lda * 2, hstepB = (size_t)HALF * g.ldb * 2;
    const size_t tstepA = 2 * hstepA, tstepB = 2 * hstepB;
    const unsigned ldsw = (unsigned)wid * 1024u;
    const int aoff = lds_byte(wr * 64 + fr, fq * 8), boff = lds_byte(wc * 32 + fr, fq * 8);
#define PG8_SA(b, h) (((b) * 2 + (h)) * HTB)
#define PG8_SB(b, h) ((4 + (b) * 2 + (h)) * HTB)
#define PG8_STAGE(bufoff, gbase, voff) do { _Pragma("unroll") for (int _i = 0; _i < 2; ++_i) \
        __builtin_amdgcn_global_load_lds((const unsigned*)((const char*)(gbase) + (voff)[_i]), (PG8_LAS unsigned*)(lds + (bufoff) + ldsw + _i * 8192), 16, 0, 0); } while (0)
#define PG8_LDA(dst, b, h) do { _Pragma("unroll") for (int m = 0; m < 4; ++m) _Pragma("unroll") for (int k = 0; k < 2; ++k) dst[m][k] = *(const PG8_LAS bf16x8*)(lds + PG8_SA(b, h) + aoff + m * 2048 + k * 1024); } while (0)
#define PG8_LDB(dst, b, h) do { _Pragma("unroll") for (int n = 0; n < 2; ++n) _Pragma("unroll") for (int k = 0; k < 2; ++k) dst[n][k] = *(const PG8_LAS bf16x8*)(lds + PG8_SB(b, h) + boff + n * 2048 + k * 1024); } while (0)
#define PG8_MMA(ai, bj, At, Bt) do { __builtin_amdgcn_s_setprio(1); _Pragma("unroll") for (int k = 0; k < 2; ++k) _Pragma("unroll") for (int m = 0; m < 4; ++m) _Pragma("unroll") for (int n = 0; n < 2; ++n) \
        acc[ai][bj][m][n] = __builtin_amdgcn_mfma_f32_16x16x32_bf16(Bt[n][k], At[m][k], acc[ai][bj][m][n], 0, 0, 0); __builtin_amdgcn_s_setprio(0); } while (0)
#define PG8_WAIT_V(n) asm volatile("s_waitcnt vmcnt(" #n ")" ::: "memory")
#define PG8_WAIT_L(n) asm volatile("s_waitcnt lgkmcnt(" #n ")" ::: "memory")
#define PG8_BAR __builtin_amdgcn_s_barrier()
#define PG8_SCHED __builtin_amdgcn_sched_barrier(0)
    Unit cur, nxt; int ui = 0;
    if (!S.next(0, cur)) return;
    f32x4 acc[2][2][4][2];
#pragma unroll
    for (int a = 0; a < 2; ++a)
#pragma unroll
        for (int b = 0; b < 2; ++b)
#pragma unroll
            for (int m = 0; m < 4; ++m)
#pragma unroll
                for (int n = 0; n < 2; ++n) acc[a][b][m][n] = (f32x4){0.f, 0.f, 0.f, 0.f};
    bf16x8 At[4][2], B0[2][2], B1[2][2];
    const char* cA = (const char*)g.A + (size_t)cur.pm * tstepA; const char* cB = (const char*)g.Bt + (size_t)cur.pn * tstepB;
    S.a_ready(cur);
    PG8_STAGE(PG8_SB(0, 0), cB, voffB); PG8_STAGE(PG8_SB(0, 1), cB + hstepB, voffB); PG8_STAGE(PG8_SA(0, 0), cA, voffA); PG8_STAGE(PG8_SA(0, 1), cA + hstepA, voffA);
    if (wr == 1) PG8_BAR;
    PG8_WAIT_V(2); PG8_BAR;
    PG8_STAGE(PG8_SB(1, 0), cB + kstep, voffB); PG8_STAGE(PG8_SA(1, 0), cA + kstep, voffA); PG8_STAGE(PG8_SB(1, 1), cB + hstepB + kstep, voffB);
    PG8_WAIT_V(6); PG8_BAR;
    for (;;) {
        const bool has_next = S.next(ui + 1, nxt);
        const char* nA = has_next ? (const char*)g.A + (size_t)nxt.pm * tstepA : cA; const char* nB = has_next ? (const char*)g.Bt + (size_t)nxt.pn * tstepB : cB;
        for (int t = 0; t < nt; t += 2) {
            const bool last = (t == nt - 2);
            const char* a1 = cA + (size_t)(t + 1) * kstep;
            const char* a2 = last ? nA : cA + (size_t)(t + 2) * kstep; const char* b2 = last ? nB : cB + (size_t)(t + 2) * kstep;
            const char* a3 = a2 + kstep; const char* b3 = b2 + kstep;
            if (last && has_next) S.a_ready(nxt);
            PG8_LDB(B0, 0, 0); PG8_LDB(B1, 0, 1); PG8_SCHED; PG8_LDA(At, 0, 0); PG8_STAGE(PG8_SA(1, 1), a1 + hstepA, voffA);
            PG8_WAIT_V(8); PG8_WAIT_L(0); PG8_BAR; PG8_MMA(0, 0, At, B0); PG8_MMA(0, 1, At, B1); PG8_BAR; PG8_SCHED;
            PG8_LDA(At, 0, 1); PG8_STAGE(PG8_SB(0, 0), b2, voffB); PG8_STAGE(PG8_SB(0, 1), b2 + hstepB, voffB); PG8_STAGE(PG8_SA(0, 0), a2, voffA);
            PG8_WAIT_V(8); PG8_WAIT_L(0); PG8_BAR; PG8_MMA(1, 0, At, B0); PG8_MMA(1, 1, At, B1); PG8_BAR; PG8_SCHED;
            PG8_LDB(B0, 1, 0); PG8_LDB(B1, 1, 1); PG8_SCHED; PG8_LDA(At, 1, 0); PG8_STAGE(PG8_SA(0, 1), a2 + hstepA, voffA);
            PG8_WAIT_V(8); PG8_WAIT_L(0); PG8_BAR; PG8_MMA(0, 0, At, B0); PG8_MMA(0, 1, At, B1); PG8_BAR; PG8_SCHED;
            PG8_LDA(At, 1, 1); PG8_STAGE(PG8_SB(1, 0), b3, voffB); PG8_STAGE(PG8_SB(1, 1), b3 + hstepB, voffB); PG8_STAGE(PG8_SA(1, 0), a3, voffA);
            PG8_WAIT_V(8); PG8_WAIT_L(0); PG8_BAR; PG8_MMA(1, 0, At, B0); PG8_MMA(1, 1, At, B1); PG8_BAR; PG8_SCHED;
        }
        if constexpr (ALIGN_EPI) { if (wr == 0) PG8_BAR; }
        if constexpr (!Epi::AFTER_DRAIN) { E(acc, cur, wr, wc, fr, fq); S.done(cur); }
        if (!has_next) break;
#pragma unroll
        for (int a = 0; a < 2; ++a)
#pragma unroll
            for (int b = 0; b < 2; ++b)
#pragma unroll
                for (int m = 0; m < 4; ++m)
#pragma unroll
                    for (int n = 0; n < 2; ++n) acc[a][b][m][n] = (f32x4){0.f, 0.f, 0.f, 0.f};
        cur = nxt; cA = nA; cB = nB; ++ui;
        if constexpr (ALIGN_EPI) { if (wr == 1) PG8_BAR; }
    }
    PG8_WAIT_V(0);
    if constexpr (!ALIGN_EPI) { if (wr == 0) PG8_BAR; }
    PG8_BAR;
#undef PG8_SA
#undef PG8_SB
#undef PG8_STAGE
#undef PG8_LDA
#undef PG8_LDB
#undef PG8_MMA
#undef PG8_WAIT_V
#undef PG8_WAIT_L
#undef PG8_BAR
#undef PG8_SCHED
}
}

constexpr int NWAVES = 8;
constexpr int BATCH = 4, SEQ = 2048, DM = 2048, DEPTH = 4, HD = 128, DFF = 5632, DIN = 6144, M = BATCH * SEQ;
constexpr int LDH = DFF + 64;
constexpr int NMOD = 9 * DM;
constexpr float EPS = 1e-6f;

#define GAS __attribute__((address_space(1)))
#define LAS __attribute__((address_space(3)))
typedef unsigned short bf16;
typedef GAS unsigned gu32;
typedef unsigned v4u __attribute__((ext_vector_type(4)));
typedef float f32x4 __attribute__((ext_vector_type(4)));
typedef short bf16x8 __attribute__((ext_vector_type(8)));
typedef short s16x4 __attribute__((ext_vector_type(4)));
typedef float f32x16 __attribute__((ext_vector_type(16)));

constexpr size_t MiB = 1u << 20;
constexpr size_t WS_CTL = 0, CTL_ZERO_BYTES = 1 * MiB;
constexpr size_t WS_MODP = 2 * MiB;
constexpr size_t WS_TAB = 22 * MiB;
constexpr size_t WS_KMEAN = 256 * 1024;
constexpr size_t WS_H = 26 * MiB;
constexpr size_t WS_Y = 58 * MiB;
constexpr size_t WS_O = 122 * MiB;
constexpr size_t WS_PROJ = 154 * MiB;
constexpr size_t WS_HID = 250 * MiB;
constexpr size_t WS_W = 340 * MiB;
constexpr size_t W_GU1 = 0, W_D1 = 44 * MiB, W_IN = 66 * MiB, W_OUT = 90 * MiB, W_GU2 = 98 * MiB, W_D2 = 142 * MiB, W_LAYER = 164 * MiB;
constexpr size_t WS_XB = WS_W + DEPTH * W_LAYER;
constexpr size_t WS_END = WS_XB + 32 * MiB;
constexpr int CW_BAR = 4096;
constexpr size_t WS_PCNT = 32 * 1024;

constexpr int RING_BYTES = 131072;
constexpr int LDSCTL_OFF = RING_BYTES;
constexpr int A_KM = LDSCTL_OFF + 256, A_LUT = A_KM + 4096, A_WS = A_LUT + 1024, A_END = A_WS + 2048;
constexpr int LDS_BYTES = 147456;
static_assert(A_END <= LDS_BYTES, "LDS map");

#define XB_TMO      128
#define XB_XCNT(j)  (256  + 64 * (j))
#define XB_XSUB(j)  (1280 + 64 * (j))
#define XB_XGEN(j)  (2304 + 64 * (j))
#define XB_TOP      3328
#define XB_TOPGEN   3392
#define XCD_BAR_WORDS 3456
#define XB_SPIN_CAP (1u << 22)

__device__ __forceinline__ unsigned xb_ld(unsigned* p)              { return __hip_atomic_load(p, __ATOMIC_RELAXED, __HIP_MEMORY_SCOPE_AGENT); }
__device__ __forceinline__ unsigned xb_add(unsigned* p, unsigned v) { return __hip_atomic_fetch_add(p, v, __ATOMIC_RELAXED, __HIP_MEMORY_SCOPE_AGENT); }
__device__ __forceinline__ unsigned xb_xcc_id() { return (unsigned)__builtin_amdgcn_s_getreg((3 << 11) | 20) & 0xFu; }
#define XB_SPIN(cond, bar) do { unsigned _sp = 0; while (cond) { __builtin_amdgcn_s_sleep(1); \
    if ((++_sp & 255u) == 0u) { if (xb_ld(&(bar)[XB_TMO])) break; if (_sp > XB_SPIN_CAP) { atomicAdd(&(bar)[XB_TMO], 1u); break; } } } } while (0)

struct XcdBarrier { unsigned* bar; unsigned x; volatile LAS unsigned* st; };

__device__ __forceinline__ XcdBarrier xcd_barrier_post(unsigned* bar, volatile LAS unsigned* st) {
    XcdBarrier b; b.bar = bar; b.x = xb_xcc_id(); b.st = st;
    if (threadIdx.x == 0) (void)xb_add(&bar[XB_XCNT(b.x)], 1u);
    return b;
}
__device__ __forceinline__ void xcd_barrier_complete(unsigned* bar, unsigned x, unsigned& nloc, unsigned& nx) {
    const unsigned G = gridDim.x * gridDim.y * gridDim.z;
    unsigned sum, cnt, mine, sp = 0u;
    for (;;) {
        sum = 0u; cnt = 0u; mine = 0u;
#pragma unroll
        for (unsigned j = 0; j < 16; ++j) { const unsigned c = xb_ld(&bar[XB_XCNT(j)]); sum += c; cnt += (c > 0u) ? 1u : 0u; mine = (j == x) ? c : mine; }
        if (sum == G) break;
        __builtin_amdgcn_s_sleep(1);
        if ((++sp & 255u) == 0u) { if (xb_ld(&bar[XB_TMO])) break; if (sp > XB_SPIN_CAP) { atomicAdd(&bar[XB_TMO], 1u); break; } }
    }
    nloc = mine > 0u ? mine : 1u; nx = cnt > 0u ? cnt : 1u;
}
__device__ __forceinline__ void xcd_barrier(const XcdBarrier& b) {
    asm volatile("s_waitcnt vmcnt(0)" ::: "memory");
    __syncthreads();
    if (threadIdx.x == 0) {
        unsigned* bar = b.bar;
        __builtin_amdgcn_s_waitcnt(0);
        unsigned nloc = b.st[0], nx = b.st[1];
        if (nloc == 0u) { xcd_barrier_complete(bar, b.x, nloc, nx); b.st[0] = nloc; b.st[1] = nx; }
        const unsigned old = xb_add(&bar[XB_XSUB(b.x)], 1u);
        const unsigned gen = old / nloc;
        if (old + 1u == (gen + 1u) * nloc) {
            __builtin_amdgcn_fence(__ATOMIC_RELEASE, "agent");
            asm volatile("s_waitcnt vmcnt(0)" ::: "memory");
            const unsigned og = xb_add(&bar[XB_TOP], 1u);
            const unsigned tg = og / nx;
            if (og + 1u == (tg + 1u) * nx) xb_add(&bar[XB_TOPGEN], 1u);
            else XB_SPIN(xb_ld(&bar[XB_TOPGEN]) == tg, bar);
            __builtin_amdgcn_fence(__ATOMIC_ACQUIRE, "agent");
            xb_add(&bar[XB_XGEN(b.x)], 1u);
            asm volatile("s_waitcnt vmcnt(0)" ::: "memory");
        } else {
            XB_SPIN(xb_ld(&bar[XB_XGEN(b.x)]) == gen, bar);
            __builtin_amdgcn_fence(__ATOMIC_ACQUIRE, "agent");
            asm volatile("s_waitcnt vmcnt(0)" ::: "memory");
        }
    }
    __syncthreads();
}

#define LDS_WAIT() asm volatile("s_waitcnt lgkmcnt(0)" ::: "memory")
#define VM_WAIT() asm volatile("s_waitcnt vmcnt(0)" ::: "memory")
__device__ __forceinline__ unsigned f2bf(float f) { unsigned u = __builtin_bit_cast(unsigned, f); return (u + 0x7fffu + ((u >> 16) & 1u)) >> 16; }
__device__ __forceinline__ unsigned pk2(float lo, float hi) { return f2bf(lo) | (f2bf(hi) << 16); }
__device__ __forceinline__ float bf2f(unsigned short b) { return __builtin_bit_cast(float, ((unsigned)b) << 16); }
__device__ __forceinline__ float wave_sum(float v) {
#define WS_DPP(x, ctrl, rmask) __builtin_bit_cast(float, __builtin_amdgcn_update_dpp(0, __builtin_bit_cast(int, (x)), (ctrl), (rmask), 0xf, true))
    v += WS_DPP(v, 0x111, 0xf);
    v += WS_DPP(v, 0x112, 0xf);
    v += WS_DPP(v, 0x114, 0xf);
    v += WS_DPP(v, 0x118, 0xf);
    v += WS_DPP(v, 0x142, 0xa);
    v += WS_DPP(v, 0x143, 0xc);
#undef WS_DPP
    return __builtin_bit_cast(float, __builtin_amdgcn_readlane(__builtin_bit_cast(int, v), 63));
}
__device__ __forceinline__ float silu_f(float x) { return x / (1.0f + __expf(-x)); }

struct Frame {
    LAS unsigned char* lds;
    int tid, lane, wave, G, gw, NGW;
    float* out; unsigned char* ws;
    const __attribute__((address_space(4))) unsigned long long* inp;
    __device__ __forceinline__ const float* in(int i) const { const __attribute__((address_space(4))) unsigned long long* p = inp; asm volatile("" : "+s"(p)); return (const float*)(const GAS float*)p[i]; }
};

__device__ __forceinline__ void p0_transpose_item(const float* W, int K, int N, bf16* WT, int mode, LAS unsigned char* scr, int item, int lane) {
    const int nblk = N / 64, kb = item / nblk, nb = item % nblk, k0 = 64 * kb, n0 = 64 * nb;
    const int d0 = mode == 0 ? n0 : ((n0 >> 7) * 256 + (n0 & 127) + (mode == 2 ? 128 : 0));
    const int kq = lane >> 4, nq = 4 * (lane & 15);
    const float* src = W + (size_t)(k0 + 2 * kq) * N + n0 + nq;
    f32x4 va[8], vb[8];
#pragma unroll
    for (int i = 0; i < 8; ++i) { va[i] = __builtin_nontemporal_load((const f32x4*)(src + (size_t)(8 * i) * N)); vb[i] = __builtin_nontemporal_load((const f32x4*)(src + (size_t)(8 * i + 1) * N)); }
#pragma unroll
    for (int i = 0; i < 8; ++i) {
#pragma unroll
        for (int c = 0; c < 4; ++c) *(LAS unsigned*)(scr + (nq + c) * 136 + (8 * i + 2 * kq) * 2) = pk2(va[i][c], vb[i][c]); }
    LDS_WAIT(); asm volatile("" ::: "memory");
    const int ch = lane & 7;
#pragma unroll
    for (int j = 0; j < 8; ++j) { const int n = 8 * j + (lane >> 3);
        const LAS unsigned long long* p = (const LAS unsigned long long*)(scr + n * 136 + ch * 16);
        const unsigned long long lo = p[0], hi2 = p[1];
        v4u o; o.x = (unsigned)lo; o.y = (unsigned)(lo >> 32); o.z = (unsigned)hi2; o.w = (unsigned)(hi2 >> 32);
        *(GAS v4u*)(WT + (size_t)(d0 + n) * K + k0 + 8 * ch) = o; }
    LDS_WAIT(); asm volatile("" ::: "memory");
}

__device__ __forceinline__ void p0_ada_item(Frame& F, int item, const LAS float* cact) {
    const int cc = item % 288, kc = item / 288, layer = cc / 72, col0 = (cc % 72) * 256, k0 = kc * 128;
    const float* W = F.in(2) + (size_t)layer * DM * NMOD + (size_t)k0 * NMOD + col0 + 4 * F.lane;
    f32x4 acc[4];
#pragma unroll
    for (int b = 0; b < 4; ++b) acc[b] = (f32x4){0.f, 0.f, 0.f, 0.f};
#pragma unroll 8
    for (int k = 0; k < 128; ++k) {
        const f32x4 w = __builtin_nontemporal_load((const f32x4*)(W + (size_t)k * NMOD));
        const f32x4 ca = *(const LAS f32x4*)(cact + (k0 + k) * 4);
        acc[0] += ca[0] * w; acc[1] += ca[1] * w; acc[2] += ca[2] * w; acc[3] += ca[3] * w;
    }
    float* P = (float*)(F.ws + WS_MODP) + ((size_t)(kc * DEPTH + layer) * BATCH) * NMOD + col0 + 4 * F.lane;
#pragma unroll
    for (int b = 0; b < 4; ++b) *(f32x4*)(P + (size_t)b * NMOD) = acc[b];
}

constexpr int P0_N_ADA = 288 * 16;
constexpr int P0_I_GU = (DM / 64) * (DFF / 64), P0_I_D = (DFF / 64) * (DM / 64), P0_I_IN = (DM / 64) * (DIN / 64), P0_I_OUT = (DM / 64) * (DM / 64);
constexpr int P0_I_LAYER = 4 * P0_I_GU + 2 * P0_I_D + P0_I_IN + P0_I_OUT;
#ifndef HIDE_H
#define HIDE_H 6656
#endif
constexpr int HIDE_T = 2048;
constexpr int HIDE_WGS = 16;
constexpr int HIDE_N = HIDE_H + HIDE_T;
__host__ __device__ constexpr int hide_cut(int k) { return (k >> 1) * P0_I_LAYER + ((k & 1) ? (4 * P0_I_GU + P0_I_D + P0_I_IN + P0_I_OUT) : 2 * P0_I_GU); }
#ifndef HIDE_NE
#define HIDE_NE 12544
#endif
#ifndef HIDE_NO
#define HIDE_NO 8448
#endif
__host__ __device__ constexpr int hide_cap(int k) { return HIDE_N == 0 ? 0 : ((k & 1) ? HIDE_NO : HIDE_NE); }
__host__ __device__ constexpr int hide_start(int k) { int e = 0, st = 0; for (int i = 0; i <= k; ++i) { st = hide_cut(i) > e ? hide_cut(i) : e; e = st + hide_cap(i); if (e > DEPTH * P0_I_LAYER) e = DEPTH * P0_I_LAYER; } return st; }
__host__ __device__ constexpr int hide_len(int k) { const int st = hide_start(k); const int e = st + hide_cap(k) > DEPTH * P0_I_LAYER ? DEPTH * P0_I_LAYER : st + hide_cap(k); return e > st ? e - st : 0; }
__device__ __forceinline__ void p0_layer_item(Frame& F, int l, int r, LAS unsigned char* scr, int lane) {
    unsigned char* wl = F.ws + WS_W + (size_t)l * W_LAYER;
    const size_t oGU = (size_t)l * DM * DFF, oD = (size_t)l * DFF * DM;
    if (r < P0_I_GU) { p0_transpose_item(F.in(6) + oGU, DM, DFF, (bf16*)(wl + W_GU1), 1, scr, r, lane); return; } r -= P0_I_GU;
    if (r < P0_I_GU) { p0_transpose_item(F.in(7) + oGU, DM, DFF, (bf16*)(wl + W_GU1), 2, scr, r, lane); return; } r -= P0_I_GU;
    if (r < P0_I_D) { p0_transpose_item(F.in(8) + oD, DFF, DM, (bf16*)(wl + W_D1), 0, scr, r, lane); return; } r -= P0_I_D;
    if (r < P0_I_IN) { p0_transpose_item(F.in(9) + (size_t)l * DM * DIN, DM, DIN, (bf16*)(wl + W_IN), 0, scr, r, lane); return; } r -= P0_I_IN;
    if (r < P0_I_OUT) { p0_transpose_item(F.in(11) + (size_t)l * DM * DM, DM, DM, (bf16*)(wl + W_OUT), 0, scr, r, lane); return; } r -= P0_I_OUT;
    if (r < P0_I_GU) { p0_transpose_item(F.in(13) + oGU, DM, DFF, (bf16*)(wl + W_GU2), 1, scr, r, lane); return; } r -= P0_I_GU;
    if (r < P0_I_GU) { p0_transpose_item(F.in(14) + oGU, DM, DFF, (bf16*)(wl + W_GU2), 2, scr, r, lane); return; } r -= P0_I_GU;
    p0_transpose_item(F.in(15) + oD, DFF, DM, (bf16*)(wl + W_D2), 0, scr, r, lane);
}
struct TDesc { const float* src; bf16* dst; int N, K; };
__device__ __forceinline__ TDesc t_decode(Frame& F, int g, int lane) {
    const int l = g / P0_I_LAYER; int r = g % P0_I_LAYER;
    unsigned char* wl = F.ws + WS_W + (size_t)l * W_LAYER;
    const size_t oGU = (size_t)l * DM * DFF, oD = (size_t)l * DFF * DM;
    const float* W; bf16* WT; int K, N, mode;
    if (r < P0_I_GU) { W = F.in(6) + oGU; K = DM; N = DFF; WT = (bf16*)(wl + W_GU1); mode = 1; }
    else if ((r -= P0_I_GU) < P0_I_GU) { W = F.in(7) + oGU; K = DM; N = DFF; WT = (bf16*)(wl + W_GU1); mode = 2; }
    else if ((r -= P0_I_GU) < P0_I_D) { W = F.in(8) + oD; K = DFF; N = DM; WT = (bf16*)(wl + W_D1); mode = 0; }
    else if ((r -= P0_I_D) < P0_I_IN) { W = F.in(9) + (size_t)l * DM * DIN; K = DM; N = DIN; WT = (bf16*)(wl + W_IN); mode = 0; }
    else if ((r -= P0_I_IN) < P0_I_OUT) { W = F.in(11) + (size_t)l * DM * DM; K = DM; N = DM; WT = (bf16*)(wl + W_OUT); mode = 0; }
    else if ((r -= P0_I_OUT) < P0_I_GU) { W = F.in(13) + oGU; K = DM; N = DFF; WT = (bf16*)(wl + W_GU2); mode = 1; }
    else if ((r -= P0_I_GU) < P0_I_GU) { W = F.in(14) + oGU; K = DM; N = DFF; WT = (bf16*)(wl + W_GU2); mode = 2; }
    else { r -= P0_I_GU; W = F.in(15) + oD; K = DFF; N = DM; WT = (bf16*)(wl + W_D2); mode = 0; }
    const int nblk = N / 64, kb = r / nblk, nb = r % nblk, k0 = 64 * kb, n0 = 64 * nb;
    const int d0 = mode == 0 ? n0 : ((n0 >> 7) * 256 + (n0 & 127) + (mode == 2 ? 128 : 0));
    TDesc d; d.N = N; d.K = K;
    d.src = W + (size_t)(k0 + 2 * (lane >> 4)) * N + n0 + 4 * (lane & 15);
    d.dst = WT + (size_t)(d0 + (lane >> 3)) * K + k0 + 8 * (lane & 7);
    return d;
}
__device__ __forceinline__ void t_load(const TDesc& d, f32x4 (&va)[8], f32x4 (&vb)[8]) {
#pragma unroll
    for (int i = 0; i < 8; ++i) { va[i] = __builtin_nontemporal_load((const f32x4*)(d.src + (size_t)(8 * i) * d.N)); vb[i] = __builtin_nontemporal_load((const f32x4*)(d.src + (size_t)(8 * i + 1) * d.N)); }
}
__device__ __forceinline__ void t_lds_write(LAS unsigned char* scr, const f32x4 (&va)[8], const f32x4 (&vb)[8], int lane) {
    const int kq = lane >> 4, nq = 4 * (lane & 15);
#pragma unroll
    for (int i = 0; i < 8; ++i) {
#pragma unroll
        for (int c = 0; c < 4; ++c) *(LAS unsigned*)(scr + (nq + c) * 136 + (8 * i + 2 * kq) * 2) = pg8::cvt_pk_bf16(va[i][c], vb[i][c]); }
}
__device__ __forceinline__ void t_store(const LAS unsigned char* scr, const TDesc& d, int lane) {
    const int ch = lane & 7;
#pragma unroll
    for (int j = 0; j < 8; ++j) { const int n = 8 * j + (lane >> 3);
        const LAS unsigned long long* p = (const LAS unsigned long long*)(scr + n * 136 + ch * 16);
        const unsigned long long lo = p[0], hi2 = p[1];
        v4u o; o.x = (unsigned)lo; o.y = (unsigned)(lo >> 32); o.z = (unsigned)hi2; o.w = (unsigned)(hi2 >> 32);
        *(GAS v4u*)(d.dst + (size_t)(8 * j) * d.K) = o; }
}
template <bool SKIP> __device__ __forceinline__ int t_index(int it, int first) {
    int g = first + it;
    if (SKIP) {
#pragma unroll
        for (int k = 0; k < 2 * DEPTH; ++k) if (g >= hide_start(k)) g += hide_len(k); }
    return g;
}
template <bool SKIP> __device__ __forceinline__ void convert_list(Frame& F, int first, int count, int cw, int ncw) {
    LAS unsigned char* scr = F.lds + F.wave * 8704;
    int lane_ = F.lane; asm volatile("" : "+v"(lane_));
    const int lane = lane_;
    if (cw >= count) return;
    f32x4 va[8], vb[8];
    TDesc d = t_decode(F, t_index<SKIP>(cw, first), lane), dn = d;
    t_load(d, va, vb);
    for (int it = cw; it < count; it += ncw) {
        t_lds_write(scr, va, vb, lane);
        const bool more = it + ncw < count;
        if (more) { dn = t_decode(F, t_index<SKIP>(it + ncw, first), lane); t_load(dn, va, vb); }
        LDS_WAIT(); asm volatile("" ::: "memory");
        t_store(scr, d, lane);
        LDS_WAIT(); asm volatile("" ::: "memory");
        d = dn;
    }
}
__device__ __forceinline__ void p0_hidden(Frame& F, int first, int count, int cw, int ncw) {
    convert_list<false>(F, first, count, cw, ncw);
}
__device__ __forceinline__ void convert_dynamic(Frame& F, int first, int count, unsigned* ctr, unsigned grab) {
    volatile LAS unsigned* slot = (volatile LAS unsigned*)(F.lds + LDSCTL_OFF) + 5;
    for (;;) {
        if (F.tid == 0) slot[0] = __hip_atomic_fetch_add(ctr, grab, __ATOMIC_RELAXED, __HIP_MEMORY_SCOPE_AGENT);
        __syncthreads();
        const int u0 = (int)slot[0] * 8;
        if (u0 >= count) break;
        const int n = (int)grab * 8 < count - u0 ? (int)grab * 8 : count - u0;
        convert_list<false>(F, first + u0, n, F.wave, NWAVES);
        __syncthreads();
    }
}
__device__ __forceinline__ void p0_prologue(Frame& F) {
    LAS float* cact = (LAS float*)(F.lds + 98304);
    for (int i = F.tid; i < BATCH * DM; i += NWAVES * 64) { const int b = i / DM, k = i % DM; cact[k * 4 + b] = silu_f(F.in(1)[i]); }
    __syncthreads();
    const bool hiding = (F.G == 256) && (HIDE_N > 0);
    int nhid = 0;
    if (hiding) {
#pragma unroll
        for (int k = 0; k < 2 * DEPTH; ++k) nhid += hide_len(k); }
    for (int it = F.gw; it < P0_N_ADA; it += F.NGW) p0_ada_item(F, it, cact);
    const int nlist = DEPTH * P0_I_LAYER - nhid;
    if (hiding) {
        const int nheavy = P0_N_ADA % F.NGW, nlight = F.NGW - nheavy;
        int pre = 5 * nlight; if (pre > nlist) pre = nlist;
        if (F.gw >= nheavy) convert_list<true>(F, 0, pre, F.gw - nheavy, nlight);
        convert_list<true>(F, pre, nlist - pre, F.gw, F.NGW);
    } else convert_list<false>(F, 0, nlist, F.gw, F.NGW);
}

__device__ __forceinline__ void p0_mod_tables(Frame& F) {
    const float* P = (const float*)(F.ws + WS_MODP); float* T = (float*)(F.ws + WS_TAB);
    const int total = DEPTH * 3 * BATCH * DM;
    for (int i = blockIdx.x * (NWAVES * 64) + F.tid; i < total; i += F.G * NWAVES * 64) {
        const int c = i % DM, b = (i / DM) % BATCH, s = (i / (DM * BATCH)) % 3, l = i / (DM * BATCH * 3);
        float v[3];
#pragma unroll
        for (int j = 0; j < 3; ++j) { const int col = (s * 3 + j) * DM + c; float a = F.in(3)[(size_t)l * NMOD + col];
            for (int kc = 0; kc < 16; ++kc) a += P[((size_t)(kc * DEPTH + l) * BATCH + b) * NMOD + col];
            v[j] = a; }
        const float gpre = F.in(4)[(size_t)(l * 3 + s) * DM + c], gpost = F.in(5)[(size_t)(l * 3 + s) * DM + c];
        float* t = T + ((size_t)((l * 3 + s) * BATCH + b) * 3) * DM + c;
        t[0] = (s == 1 ? 1.0f : 0.5f) * v[2] * gpost; t[DM] = gpre * (1.0f + v[1]); t[2 * DM] = v[0];
    }
}

__device__ __forceinline__ void thin_phase(Frame& F, int ps, int ns, int rows0) {
    const float* T = (const float*)(F.ws + WS_TAB); const bf16* Y = (const bf16*)(F.ws + WS_Y); bf16* H = (bf16*)(F.ws + WS_H); bf16* XB = (bf16*)(F.ws + WS_XB);
    const float* xin = F.in(0);
    int lane_ = F.lane; asm volatile("" : "+v"(lane_));
    const int lane = lane_;
#define UNPK4(w) (f32x4){bf2f((unsigned short)((w) & 0xffffu)), bf2f((unsigned short)(((w) >> 16) & 0xffffu)), bf2f((unsigned short)(((w) >> 32) & 0xffffu)), bf2f((unsigned short)((w) >> 48))}
    for (int m = (rows0 >= 0 ? rows0 : F.gw * 4); m < (rows0 >= 0 ? rows0 + 4 : M); m += F.NGW * 4) {
#pragma unroll 1
        for (int i = 0; i < 4; ++i) {
            const int row = m + i, b = row / SEQ;
            f32x4 x[8];
            if (ps < 0) { const GAS f32x4* xr = (const GAS f32x4*)(xin + (size_t)row * DM) + lane;
#pragma unroll
                for (int j = 0; j < 8; ++j) x[j] = xr[64 * j];
            } else { const GAS unsigned long long* xr = (const GAS unsigned long long*)(XB + (size_t)row * DM) + lane;
#pragma unroll
                for (int j = 0; j < 8; ++j) { const unsigned long long w = xr[64 * j]; x[j] = UNPK4(w); } }
            if (ps >= 0) {
                const GAS unsigned long long* yr = (const GAS unsigned long long*)(Y + (size_t)row * DM) + lane;
                const GAS f32x4* ta = (const GAS f32x4*)(T + ((size_t)(ps * BATCH + b) * 3) * DM) + lane;
                f32x4 y[8]; float ss = 0.f;
#pragma unroll
                for (int j = 0; j < 8; ++j) { const unsigned long long w = yr[64 * j]; y[j] = UNPK4(w);
                    ss += (y[j].x * y[j].x + y[j].y * y[j].y) + (y[j].z * y[j].z + y[j].w * y[j].w); }
                const float r = 1.0f / sqrtf(wave_sum(ss) * (1.0f / DM) + EPS);
#pragma unroll
                for (int j = 0; j < 8; ++j) x[j] += ta[64 * j] * (y[j] * r);
            }
            if (ns < 0) {
                GAS f32x4* xo = (GAS f32x4*)(F.out + (size_t)row * DM) + lane;
#pragma unroll
                for (int j = 0; j < 8; ++j) xo[64 * j] = x[j];
            } else {
                GAS unsigned long long* xo = (GAS unsigned long long*)(XB + (size_t)row * DM) + lane;
#pragma unroll
                for (int j = 0; j < 8; ++j) xo[64 * j] = (unsigned long long)pk2(x[j].x, x[j].y) | ((unsigned long long)pk2(x[j].z, x[j].w) << 32);
                float ss = 0.f;
#pragma unroll
                for (int j = 0; j < 8; ++j) ss += (x[j].x * x[j].x + x[j].y * x[j].y) + (x[j].z * x[j].z + x[j].w * x[j].w);
                const float r = 1.0f / sqrtf(wave_sum(ss) * (1.0f / DM) + EPS);
                const GAS f32x4* tb = (const GAS f32x4*)(T + ((size_t)(ns * BATCH + b) * 3 + 1) * DM) + lane;
                const GAS f32x4* tc = (const GAS f32x4*)(T + ((size_t)(ns * BATCH + b) * 3 + 2) * DM) + lane;
                GAS unsigned long long* o8 = (GAS unsigned long long*)(H + (size_t)row * DM) + lane;
#pragma unroll
                for (int j = 0; j < 8; ++j) { const f32x4 h = (x[j] * r) * tb[64 * j] + tc[64 * j];
                    o8[64 * j] = (unsigned long long)pk2(h.x, h.y) | ((unsigned long long)pk2(h.z, h.w) << 32); }
            }
        }
    }
#undef UNPK4
}

struct ThinPre { unsigned long long xw[4][8]; };
__device__ __forceinline__ void thin4_tables(Frame& F, int ps, int ns, int row0) {
    const float* T = (const float*)(F.ws + WS_TAB); const int b = row0 / SEQ;
    int t_ = F.tid; asm volatile("" : "+v"(t_));
    const GAS f32x4* ta = (const GAS f32x4*)(T + ((size_t)(ps * BATCH + b) * 3) * DM) + t_;
    const GAS f32x4* tb = (const GAS f32x4*)(T + ((size_t)((ns < 0 ? 0 : ns) * BATCH + b) * 3 + 1) * DM) + t_;
    LAS f32x4* L = (LAS f32x4*)F.lds + t_;
    L[0] = ta[0]; L[512] = tb[0]; L[1024] = tb[512];
}
__device__ __forceinline__ void thin4_prefetch(Frame& F, int row0, ThinPre& P) {
    int lane_ = F.lane; asm volatile("" : "+v"(lane_));
    const GAS unsigned long long* xr = (const GAS unsigned long long*)((const bf16*)(F.ws + WS_XB) + (size_t)row0 * DM) + lane_;
#pragma unroll
    for (int i = 0; i < 4; ++i)
#pragma unroll
        for (int j = 0; j < 8; ++j) P.xw[i][j] = xr[(size_t)i * (DM / 4) + 64 * j];
}
__device__ __forceinline__ void thin4_rows(Frame& F, int ps, int ns, int row0, const ThinPre& P) {
    const float* T = (const float*)(F.ws + WS_TAB); const bf16* Y = (const bf16*)(F.ws + WS_Y); bf16* H = (bf16*)(F.ws + WS_H); bf16* XB = (bf16*)(F.ws + WS_XB);
    int lane_ = F.lane; asm volatile("" : "+v"(lane_));
    const int lane = lane_, b = row0 / SEQ;
#define UNPK4(w) (f32x4){bf2f((unsigned short)((w) & 0xffffu)), bf2f((unsigned short)(((w) >> 16) & 0xffffu)), bf2f((unsigned short)(((w) >> 32) & 0xffffu)), bf2f((unsigned short)((w) >> 48))}
    const GAS unsigned long long* yr = (const GAS unsigned long long*)(Y + (size_t)row0 * DM) + lane;
    const LAS f32x4* ta = (const LAS f32x4*)F.lds + lane;
    const LAS f32x4* tb = ta + 512; const LAS f32x4* tc = ta + 1024;
    unsigned long long yw[4][8];
#pragma unroll
    for (int i = 0; i < 4; ++i)
#pragma unroll
        for (int j = 0; j < 8; ++j) yw[i][j] = yr[(size_t)i * (DM / 4) + 64 * j];
#pragma unroll
    for (int i = 0; i < 4; ++i) {
        const int row = row0 + i;
        f32x4 x[8], y[8]; float ss = 0.f;
#pragma unroll
        for (int j = 0; j < 8; ++j) { x[j] = UNPK4(P.xw[i][j]); y[j] = UNPK4(yw[i][j]); ss += (y[j].x * y[j].x + y[j].y * y[j].y) + (y[j].z * y[j].z + y[j].w * y[j].w); }
        const float r = 1.0f / sqrtf(wave_sum(ss) * (1.0f / DM) + EPS);
#pragma unroll
        for (int j = 0; j < 8; ++j) x[j] += ta[64 * j] * (y[j] * r);
        if (ns < 0) { GAS f32x4* xo = (GAS f32x4*)(F.out + (size_t)row * DM) + lane;
#pragma unroll
            for (int j = 0; j < 8; ++j) xo[64 * j] = x[j];
        } else {
            GAS unsigned long long* xo = (GAS unsigned long long*)(XB + (size_t)row * DM) + lane;
            float s2 = 0.f;
#pragma unroll
            for (int j = 0; j < 8; ++j) { xo[64 * j] = (unsigned long long)pk2(x[j].x, x[j].y) | ((unsigned long long)pk2(x[j].z, x[j].w) << 32);
                s2 += (x[j].x * x[j].x + x[j].y * x[j].y) + (x[j].z * x[j].z + x[j].w * x[j].w); }
            const float r2 = 1.0f / sqrtf(wave_sum(s2) * (1.0f / DM) + EPS);
            GAS unsigned long long* o8 = (GAS unsigned long long*)(H + (size_t)row * DM) + lane;
#pragma unroll
            for (int j = 0; j < 8; ++j) { const f32x4 h = (x[j] * r2) * tb[64 * j] + tc[64 * j];
                o8[64 * j] = (unsigned long long)pk2(h.x, h.y) | ((unsigned long long)pk2(h.z, h.w) << 32); }
        }
    }
#undef UNPK4
}

namespace att {
constexpr int LDP = HD, LDO = DM;
constexpr float SCALE = 0.08838834764831845f, LOG2E = 1.4426950408889634f, CS = SCALE * LOG2E;
constexpr int TILE_B = 16384, L_V = 0, L_K = 4 * TILE_B;
#define SBAR() __builtin_amdgcn_sched_barrier(0)
__device__ __forceinline__ int crow(int r, int hi) { return (r & 3) + 8 * (r >> 2) + 4 * hi; }
__device__ __forceinline__ unsigned cvtpk(float lo, float hi) { unsigned r; asm volatile("v_cvt_pk_bf16_f32 %0, %1, %2" : "=v"(r) : "v"(lo), "v"(hi)); return r; }
__device__ __forceinline__ int kf(int row) { return (row & 3) | (((row >> 2) & 1) << 2) | (((row >> 5) & 1) << 3); }
__device__ __forceinline__ int kswz(int row, int colB) { return row * 256 + (colB ^ (kf(row) << 4)); }
__device__ __forceinline__ int v_st(int k, int c) { const int kk = (k & ~0xC) | ((k & 4) << 1) | ((k & 8) >> 1); return ((kk >> 3) * 4 + (c >> 5)) * 512 + ((kk & 7) * 32 + (c & 31)) * 2; }
__device__ __forceinline__ int v_sigma(int a) { return 16 * ((a >> 3) & 3) + 8 * (a >> 5) + (a & 7); }
__device__ __forceinline__ int v_rd_base(int lane) { return ((lane & 3) << 3) | (((lane >> 2) & 3) << 6) | (((lane >> 4) & 1) << 5) | (((lane >> 5) & 1) << 8); }
constexpr int v_rd_off(int d0, int ks, int half) { return d0 * 512 + ks * 4096 + half * 2048; }
template <int OFF> __device__ __forceinline__ s16x4 tr_read(int vb) { s16x4 r; asm volatile("ds_read_b64_tr_b16 %0, %1 offset:%2" : "=&v"(r) : "v"(vb), "i"(OFF) : "memory"); return r; }
template <int D0> __device__ __forceinline__ void pv_one(f32x16& od, int vb, bf16x8 pa0, bf16x8 pa1, bf16x8 pa2, bf16x8 pa3) {
    const s16x4 l0 = tr_read<v_rd_off(D0, 0, 0)>(vb), h0 = tr_read<v_rd_off(D0, 0, 1)>(vb), l1 = tr_read<v_rd_off(D0, 1, 0)>(vb), h1 = tr_read<v_rd_off(D0, 1, 1)>(vb);
    const s16x4 l2 = tr_read<v_rd_off(D0, 2, 0)>(vb), h2 = tr_read<v_rd_off(D0, 2, 1)>(vb), l3 = tr_read<v_rd_off(D0, 3, 0)>(vb), h3 = tr_read<v_rd_off(D0, 3, 1)>(vb);
    asm volatile("s_waitcnt lgkmcnt(0)" ::: "memory"); SBAR();
#define PK(L, H) (bf16x8){L[0], L[1], L[2], L[3], H[0], H[1], H[2], H[3]}
    od = __builtin_amdgcn_mfma_f32_32x32x16_bf16(pa0, PK(l0, h0), od, 0, 0, 0);
    od = __builtin_amdgcn_mfma_f32_32x32x16_bf16(pa1, PK(l1, h1), od, 0, 0, 0);
    od = __builtin_amdgcn_mfma_f32_32x32x16_bf16(pa2, PK(l2, h2), od, 0, 0, 0);
    od = __builtin_amdgcn_mfma_f32_32x32x16_bf16(pa3, PK(l3, h3), od, 0, 0, 0);
#undef PK
}
__device__ __forceinline__ void pv_all(f32x16* o, int vb, bf16x8 pa0, bf16x8 pa1, bf16x8 pa2, bf16x8 pa3) {
    pv_one<0>(o[0], vb, pa0, pa1, pa2, pa3); pv_one<1>(o[1], vb, pa0, pa1, pa2, pa3); pv_one<2>(o[2], vb, pa0, pa1, pa2, pa3); pv_one<3>(o[3], vb, pa0, pa1, pa2, pa3);
}
__device__ __forceinline__ float swap_max(float v) { auto rr = __builtin_amdgcn_permlane32_swap(__float_as_uint(v), __float_as_uint(v), false, false); return fmaxf(__uint_as_float(rr[0]), __uint_as_float(rr[1])); }
__device__ __forceinline__ float swap_add(float v) { auto rr = __builtin_amdgcn_permlane32_swap(__float_as_uint(v), __float_as_uint(v), false, false); return __uint_as_float(rr[0]) + __uint_as_float(rr[1]); }
__device__ __forceinline__ float swap_get(float v, int hi) { auto rr = __builtin_amdgcn_permlane32_swap(__float_as_uint(v), __float_as_uint(v), false, false); return hi ? __uint_as_float(rr[0]) : __uint_as_float(rr[1]); }
__device__ __forceinline__ void qkt(f32x16& p0, f32x16& p1, const LAS unsigned char* Kt, const bf16x8 (&qr)[8], int kbase0, int kbase1, int kxc) {
    p0 = (f32x16){}; p1 = (f32x16){};
    bf16x8 fa[2], fb[2];
#define QK_LOAD(F, c) do { const int cb = (32 * (c)) ^ kxc; F[0] = *(const LAS bf16x8*)(Kt + kbase0 + cb); F[1] = *(const LAS bf16x8*)(Kt + kbase1 + cb); } while (0)
#define QK_MMA(F, c) do { p0 = __builtin_amdgcn_mfma_f32_32x32x16_bf16(F[0], qr[c], p0, 0, 0, 0); p1 = __builtin_amdgcn_mfma_f32_32x32x16_bf16(F[1], qr[c], p1, 0, 0, 0); } while (0)
    QK_LOAD(fa, 0); QK_LOAD(fb, 1); SBAR();
    QK_MMA(fa, 0); QK_LOAD(fa, 2); SBAR(); QK_MMA(fb, 1); QK_LOAD(fb, 3); SBAR();
    QK_MMA(fa, 2); QK_LOAD(fa, 4); SBAR(); QK_MMA(fb, 3); QK_LOAD(fb, 5); SBAR();
    QK_MMA(fa, 4); QK_LOAD(fa, 6); SBAR(); QK_MMA(fb, 5); QK_LOAD(fb, 7); SBAR();
    QK_MMA(fa, 6); QK_MMA(fb, 7);
#undef QK_LOAD
#undef QK_MMA
}
__device__ __forceinline__ void pack_p(const f32x16& p0, const f32x16& p1, bf16x8& pa0, bf16x8& pa1, bf16x8& pa2, bf16x8& pa3) {
    v4u w;
    w.x = cvtpk(p0[0], p0[1]); w.y = cvtpk(p0[2], p0[3]); w.z = cvtpk(p0[4], p0[5]); w.w = cvtpk(p0[6], p0[7]); pa0 = __builtin_bit_cast(bf16x8, w);
    w.x = cvtpk(p0[8], p0[9]); w.y = cvtpk(p0[10], p0[11]); w.z = cvtpk(p0[12], p0[13]); w.w = cvtpk(p0[14], p0[15]); pa1 = __builtin_bit_cast(bf16x8, w);
    w.x = cvtpk(p1[0], p1[1]); w.y = cvtpk(p1[2], p1[3]); w.z = cvtpk(p1[4], p1[5]); w.w = cvtpk(p1[6], p1[7]); pa2 = __builtin_bit_cast(bf16x8, w);
    w.x = cvtpk(p1[8], p1[9]); w.y = cvtpk(p1[10], p1[11]); w.z = cvtpk(p1[12], p1[13]); w.w = cvtpk(p1[14], p1[15]); pa3 = __builtin_bit_cast(bf16x8, w);
}
__device__ __forceinline__ void moba_tile(f32x16& p0, f32x16& p1, const LAS float* lut, int dbase, bool sel, bool near, float& m_run, float& l_run, float& alpha,
                                          bf16x8& pa0, bf16x8& pa1, bf16x8& pa2, bf16x8& pa3) {
    const float ninf = -__builtin_inff();
    float ps = 0.f;
    if (near) {
        float pmax = ninf;
#pragma unroll
        for (int r = 0; r < 16; ++r) { const int d0_ = dbase - r, d1_ = dbase - 16 - r;
            const int c0 = d0_ < 0 ? 0 : (d0_ > 128 ? 128 : d0_), c1 = d1_ < 0 ? 0 : (d1_ > 128 ? 128 : d1_);
            float b0 = lut[c0], b1 = lut[c1]; asm volatile("" : "+v"(b0), "+v"(b1));
            p0[r] = (sel && d0_ >= 0) ? fmaf(p0[r], CS, b0) : ninf; p1[r] = (sel && d1_ >= 0) ? fmaf(p1[r], CS, b1) : ninf;
            pmax = fmaxf(pmax, fmaxf(p0[r], p1[r])); }
        pmax = swap_max(pmax);
        if (__all(pmax <= m_run + 11.5f)) alpha = 1.f;
        else { const float mn = fmaxf(m_run, pmax); alpha = __builtin_amdgcn_exp2f(m_run - mn); m_run = mn; }
#pragma unroll
        for (int r = 0; r < 16; ++r) { p0[r] = __builtin_amdgcn_exp2f(p0[r] - m_run); p1[r] = __builtin_amdgcn_exp2f(p1[r] - m_run); ps += p0[r] + p1[r]; }
    } else {
        const float bb = lut[128];
        float smax = fmaxf(p0[0], p1[0]);
#pragma unroll
        for (int r = 1; r < 16; ++r) smax = fmaxf(smax, fmaxf(p0[r], p1[r]));
        float pmax = sel ? fmaf(smax, CS, bb) : ninf;
        pmax = swap_max(pmax);
        if (__all(pmax <= m_run + 11.5f)) alpha = 1.f;
        else { const float mn = fmaxf(m_run, pmax); alpha = __builtin_amdgcn_exp2f(m_run - mn); m_run = mn; }
        const float bm = sel ? bb - m_run : ninf;
#pragma unroll
        for (int r = 0; r < 16; ++r) { p0[r] = __builtin_amdgcn_exp2f(fmaf(p0[r], CS, bm)); p1[r] = __builtin_amdgcn_exp2f(fmaf(p1[r], CS, bm)); ps += p0[r] + p1[r]; }
    }
    ps = swap_add(ps);
    l_run = l_run * alpha + ps;
    pack_p(p0, p1, pa0, pa1, pa2, pa3);
}
template <bool DIAG>
__device__ __forceinline__ void sb_elems(f32x16& P, int dm, int off, float& run) {
#pragma unroll
    for (int r = 15; r >= 0; --r) { const float t = __builtin_amdgcn_exp2f(P[r]); float u = __builtin_amdgcn_rcpf(1.0f + t); float be = 1.0f - u;
        if (DIAG) { const bool ok = dm - off - r > 0; be = ok ? be : 0.f; u = ok ? u : 1.f; }
        P[r] = be * run; run *= u; }
}
__device__ __forceinline__ void sb_finish(f32x16& p0, f32x16& p1, float run, int hi, float& Rp, bf16x8& pa0, bf16x8& pa1, bf16x8& pa2, bf16x8& pa3) {
    const float tp = swap_get(run, hi);
    const float base = Rp * (hi == 0 ? tp : 1.0f);
    Rp *= run * tp;
#pragma unroll
    for (int r = 0; r < 16; ++r) { p0[r] *= base; p1[r] *= base; }
    pack_p(p0, p1, pa0, pa1, pa2, pa3);
}

template <bool MOBA>
__device__ __forceinline__ void attn_unit(LAS unsigned char* lds, const bf16* __restrict__ proj, bf16* __restrict__ Oout, const float* __restrict__ kmean, const float* __restrict__ rel_bias,
                                          const float* __restrict__ out_gain, int b, int hd, int qblk, void* dq_out = nullptr) {
    int tid_ = threadIdx.x; asm volatile("" : "+v"(tid_));
    const int tid = tid_, wid = __builtin_amdgcn_readfirstlane(tid >> 6), lane = tid & 63, r32 = lane & 31, hi = lane >> 5;
    const int qslot = (MOBA ? 0 : 24) + hd, ocol = (MOBA ? 0 : 1024) + hd * HD;
    const size_t rowb = (size_t)b * SEQ, qcol = (size_t)qslot * M * HD, kcol = qcol + (size_t)8 * M * HD, vcol = qcol + (size_t)16 * M * HD;
    LAS unsigned char* V_lds = lds + L_V; LAS unsigned char* K_lds = lds + L_K;
    LAS float* wsc = (LAS float*)(lds + A_WS) + wid * 64;
    LAS float* km = (LAS float*)(lds + A_KM); LAS float* lut = (LAS float*)(lds + A_LUT);
    const int q0w = qblk * 256 + wid * 32, tq = q0w + r32;
    const bool trail = wid >= 4;
    unsigned voffK[2], voffV[2];
#pragma unroll
    for (int j = 0; j < 2; ++j) {
        const int r = 8 * wid + 4 * j + (lane >> 4), cs = (lane & 15) ^ kf(r);
        voffK[j] = (unsigned)(r * LDP + cs * 8) * 2u;
        const int cg = (2 * j + (lane >> 5)) & 3, kq = (lane >> 2) & 7, cc = lane & 3, kk = 8 * wid + kq;
        const int n = (kk & ~0xC) | ((kk & 4) << 1) | ((kk & 8) >> 1), a = (n & 7) | (((n >> 3) & 1) << 5) | (((n >> 4) & 3) << 3);
        voffV[j] = (unsigned)(a * LDP + 32 * cg + 8 * cc) * 2u;
    }
    const char* Kg = (const char*)(proj + rowb * LDP + kcol); const char* Vg = (const char*)(proj + rowb * LDP + vcol);
#define DMA_K(jt, slot) do { const char* kb_ = Kg + (size_t)(jt) * (64 * LDP * 2); \
    _Pragma("unroll") for (int j_ = 0; j_ < 2; ++j_) __builtin_amdgcn_global_load_lds((const unsigned*)(kb_ + voffK[j_]), (LAS unsigned*)(K_lds + (slot) * TILE_B + wid * 2048 + j_ * 1024), 16, 0, 0); } while (0)
#define DMA_V(jt, slot) do { const char* vb_ = Vg + (size_t)(jt) * (64 * LDP * 2); \
    _Pragma("unroll") for (int j_ = 0; j_ < 2; ++j_) __builtin_amdgcn_global_load_lds((const unsigned*)(vb_ + voffV[j_]), (LAS unsigned*)(V_lds + (slot) * TILE_B + wid * 2048 + j_ * 1024), 16, 0, 0); } while (0)
    const int NT = 4 * (qblk + 1);
#if DIAG_Q > 0
    unsigned long long dq_t0 = __builtin_amdgcn_s_memtime(), dq_s1 = 0, dq_s2 = 0, dq_bar = 0, dq_dw = 0, dq_pro = 0, dq_loop = 0; const unsigned long long dq_r0 = __builtin_amdgcn_s_memrealtime();
#define DQ_T() __builtin_amdgcn_s_memtime()
#define DQ_ADD(acc, expr) do { const unsigned long long a_ = DQ_T(); expr; acc += DQ_T() - a_; } while (0)
#else
#define DQ_ADD(acc, expr) do { expr; } while (0)
#endif
    bf16x8 qr[8];
    { const bf16* Qw = proj + (rowb + tq) * LDP + qcol + hi * 8;
#pragma unroll
      for (int d0 = 0; d0 < 8; ++d0) qr[d0] = *(const GAS bf16x8*)(Qw + d0 * 16); }
    DMA_K(NT - 1, 0); DMA_V(NT - 1, 0); DMA_K(NT - 2, 1); DMA_V(NT - 2, 1); DMA_K(NT - 3, 2);
    if constexpr (!MOBA) {
#pragma unroll
        for (int d0 = 0; d0 < 8; ++d0) { v4u w;
            w.x = cvtpk(bf2f((unsigned short)qr[d0][0]) * CS, bf2f((unsigned short)qr[d0][1]) * CS); w.y = cvtpk(bf2f((unsigned short)qr[d0][2]) * CS, bf2f((unsigned short)qr[d0][3]) * CS);
            w.z = cvtpk(bf2f((unsigned short)qr[d0][4]) * CS, bf2f((unsigned short)qr[d0][5]) * CS); w.w = cvtpk(bf2f((unsigned short)qr[d0][6]) * CS, bf2f((unsigned short)qr[d0][7]) * CS);
            qr[d0] = __builtin_bit_cast(bf16x8, w); } }
    unsigned selmask = 0u;
    if constexpr (MOBA) {
        for (int i = tid; i < 1024; i += NWAVES * 64) km[i] = kmean[(size_t)((b * 8 + hd) * 8) * 128 + i];
        if (tid < 129) { const int n = tid; int bk = n;
            if (n >= 16) { bk = 16 + (int)(logf((float)n / 16.0f) / logf(8.0f) * 16.0f); bk = bk > 31 ? 31 : bk; }
            lut[tid] = rel_bias[bk * 8 + hd] * LOG2E; }
        __syncthreads();
        float gv[7];
#pragma unroll
        for (int n = 0; n < 7; ++n) { float a = 0.f;
            if (n < qblk) {
#pragma unroll
                for (int d0 = 0; d0 < 8; ++d0) { const LAS f32x4* kp = (const LAS f32x4*)(km + n * 128 + d0 * 16 + hi * 8); const f32x4 k0v = kp[0], k1v = kp[1];
                    a += bf2f((unsigned short)qr[d0][0]) * k0v[0] + bf2f((unsigned short)qr[d0][1]) * k0v[1] + bf2f((unsigned short)qr[d0][2]) * k0v[2] + bf2f((unsigned short)qr[d0][3]) * k0v[3]
                       + bf2f((unsigned short)qr[d0][4]) * k1v[0] + bf2f((unsigned short)qr[d0][5]) * k1v[1] + bf2f((unsigned short)qr[d0][6]) * k1v[2] + bf2f((unsigned short)qr[d0][7]) * k1v[3]; }
                a = swap_add(a); }
            gv[n] = a; }
        const int nsel = qblk < 3 ? qblk : 3;
#pragma unroll
        for (int t = 0; t < 3; ++t) { if (t < nsel) { float best = -__builtin_inff(); unsigned bi = 0u;
#pragma unroll
            for (int n = 0; n < 7; ++n) { const bool ok = (n < qblk) && !((selmask >> n) & 1u) && (gv[n] > best); best = ok ? gv[n] : best; bi = ok ? (unsigned)n : bi; }
            selmask |= 1u << bi; } }
        selmask |= 1u << qblk;
    }
    const int kr0 = 32 * ((r32 >> 2) & 1) + (r32 & 3) + 4 * (r32 >> 3);
    const int kbase0 = kr0 * 256, kbase1 = (kr0 + 16) * 256, kxc = (16 * hi) ^ (kf(kr0) << 4);
    const int vb0 = (int)(unsigned)(uintptr_t)V_lds + v_rd_base(lane);
#define RESC(a) do { if (__any((a) < 1.f)) { if (hi == 0) wsc[r32] = (a); LDS_WAIT(); \
    _Pragma("unroll") for (int r = 0; r < 16; ++r) { const float al_ = wsc[crow(r, hi)]; _Pragma("unroll") for (int d = 0; d < 4; ++d) o[d][r] *= al_; } } } while (0)
#define T_DBASE(jt) (tq - (64 * (jt) + 32 * hi))
#define T_DIAG(jt) (((jt) >> 2) == qblk)
#define T_SEL(jt) (((selmask >> ((jt) >> 2)) & 1u) != 0u)
#define T_NEAR(jt) ((q0w - (64 * (jt) + 63)) < 128)
#define T_ACT(jt) (!T_DIAG(jt) || (64 * ((jt) & 3) <= wid * 32 + (MOBA ? 31 : 30)))
#define BAR() do { asm volatile("" ::: "memory"); __builtin_amdgcn_s_barrier(); asm volatile("" ::: "memory"); } while (0)
    f32x16 o[4];
#pragma unroll
    for (int d = 0; d < 4; ++d) o[d] = (f32x16){};
    float m_run = -1e30f, l_run = 0.f, R = 1.f, al = 1.f, bs = 1.f;
    f32x16 p0, p1; bf16x8 pa0, pa1, pa2, pa3;
#define ST_VALU(jt) do { if (T_ACT(jt)) { \
        if constexpr (MOBA) { moba_tile(p0, p1, lut, T_DBASE(jt), T_SEL(jt), T_NEAR(jt), m_run, l_run, al, pa0, pa1, pa2, pa3); RESC(al); } \
        else { bs = 1.0f; if (T_DIAG(jt)) { sb_elems<true>(p1, T_DBASE(jt), 16, bs); sb_elems<true>(p0, T_DBASE(jt), 0, bs); } else { sb_elems<false>(p1, 0, 0, bs); sb_elems<false>(p0, 0, 0, bs); } \
               sb_finish(p0, p1, bs, hi, R, pa0, pa1, pa2, pa3); } } } while (0)
#define ST_MFMA(jt, sl, more) do { if (ATT_PRIO == 1) __builtin_amdgcn_s_setprio(1); if (T_ACT(jt)) pv_all(o, vb0 + (sl) * TILE_B, pa0, pa1, pa2, pa3); \
        if ((more) && T_ACT((jt) - 1)) qkt(p0, p1, K_lds + (((sl) + 1) & 3) * TILE_B, qr, kbase0, kbase1, kxc); if (ATT_PRIO == 1) __builtin_amdgcn_s_setprio(0); } while (0)
    asm volatile("s_waitcnt vmcnt(4)" ::: "memory");
    BAR();
    qkt(p0, p1, K_lds, qr, kbase0, kbase1, kxc);
#if DIAG_Q > 0
    dq_pro = DQ_T() - dq_t0; const unsigned long long dq_l0 = DQ_T();
#endif
    volatile LAS unsigned* dflag = (volatile LAS unsigned*)(lds + A_WS);
    bool broke = false; int dq_iters = 0;
    for (int j = 0; j < NT; ++j) { ++dq_iters;
        const int jt = NT - 1 - j;
        const bool mk = j + 3 < NT, mv = j + 2 < NT;
        if (mk) DMA_K(jt - 3, (j + 3) & 3);
        if (mv) DMA_V(jt - 2, (j + 2) & 3);
        if constexpr (!MOBA) { const bool dead = __all(R == 0.f) != 0; if (lane == 0) dflag[(j & 1) * 8 + wid] = dead ? 1u : 0u; }
        if (trail && j > 0) DQ_ADD(dq_s2, ST_MFMA(jt + 1, (j - 1) & 3, true));
        DQ_ADD(dq_s1, ST_VALU(jt));
        if (!trail) DQ_ADD(dq_s2, ST_MFMA(jt, j & 3, j + 1 < NT));
        if (mk) asm volatile("s_waitcnt vmcnt(4)" ::: "memory"); else if (mv) asm volatile("s_waitcnt vmcnt(2)" ::: "memory"); else asm volatile("s_waitcnt vmcnt(0)" ::: "memory");
        if constexpr (!MOBA) LDS_WAIT();
        DQ_ADD(dq_bar, BAR());
        if constexpr (!MOBA) { unsigned all = 1u;
#pragma unroll
            for (int w = 0; w < 8; ++w) all &= dflag[(j & 1) * 8 + w];
            if (__builtin_amdgcn_readfirstlane(all) != 0u) { broke = true; break; } }
    }
    if (trail && !broke) ST_MFMA(0, (NT - 1) & 3, false);
    asm volatile("s_waitcnt vmcnt(0)" ::: "memory");
    BAR();
#if DIAG_Q > 0
    dq_loop = DQ_T() - dq_l0;
#endif
#undef ST_VALU
#undef ST_MFMA
#undef DMA_K
#undef DMA_V
#undef RESC
    float rl[16];
    if constexpr (MOBA) { if (hi == 0) wsc[32 + r32] = l_run; LDS_WAIT();
#pragma unroll
        for (int r = 0; r < 16; ++r) rl[r] = 1.0f / wsc[32 + crow(r, hi)];
    } else {
#pragma unroll
        for (int r = 0; r < 16; ++r) rl[r] = 1.0f;
    }
    float gn[4];
#pragma unroll
    for (int d = 0; d < 4; ++d) gn[d] = out_gain[ocol + 32 * d + r32];
    LAS unsigned char* ost = lds + wid * 8192;
#pragma unroll
    for (int r = 0; r < 16; ++r) {
        float v[4]; float ss = 0.f;
#pragma unroll
        for (int d = 0; d < 4; ++d) { v[d] = o[d][r] * rl[r]; ss += v[d] * v[d]; }
        {
#define AT_DPP(x, ctrl) __builtin_bit_cast(float, __builtin_amdgcn_update_dpp(0, __builtin_bit_cast(int, (x)), (ctrl), 0xf, 0xf, true))
            ss += AT_DPP(ss, 0x111); ss += AT_DPP(ss, 0x112); ss += AT_DPP(ss, 0x114); ss += AT_DPP(ss, 0x118);
#undef AT_DPP
            const float t0 = __builtin_bit_cast(float, __builtin_amdgcn_readlane(__builtin_bit_cast(int, ss), 15)), t1 = __builtin_bit_cast(float, __builtin_amdgcn_readlane(__builtin_bit_cast(int, ss), 31));
            const float t2 = __builtin_bit_cast(float, __builtin_amdgcn_readlane(__builtin_bit_cast(int, ss), 47)), t3 = __builtin_bit_cast(float, __builtin_amdgcn_readlane(__builtin_bit_cast(int, ss), 63));
            ss = hi ? (t2 + t3) : (t0 + t1); }
        const float rs = 1.0f / sqrtf(ss * (1.0f / HD) + EPS);
#pragma unroll
        for (int d = 0; d < 4; ++d) *(LAS unsigned short*)(ost + crow(r, hi) * 256 + (32 * d + r32) * 2) = (unsigned short)f2bf(v[d] * rs * gn[d]);
    }
    LDS_WAIT(); asm volatile("" ::: "memory");
    { bf16* Ob = Oout + (rowb + q0w) * LDO + ocol;
#pragma unroll
      for (int i = 0; i < 8; ++i) { const int row = (lane >> 4) + 4 * i, ch = lane & 15;
        const v4u w = *(const LAS v4u*)(ost + row * 256 + ch * 16);
        *(GAS v4u*)(Ob + (size_t)row * LDO + ch * 8) = w; } }
    LDS_WAIT(); asm volatile("" ::: "memory");
    __syncthreads();
#if DIAG_Q > 0
    if (blockIdx.x == DIAG_BX && wid == DIAG_W && lane == 0 && (MOBA ? !DIAG_SB : DIAG_SB)) {
        const unsigned long long tot = DQ_T() - dq_t0, rt = __builtin_amdgcn_s_memrealtime() - dq_r0;
        const unsigned long long v = DIAG_Q == 1 ? tot : DIAG_Q == 2 ? dq_s1 : DIAG_Q == 3 ? dq_s2 : DIAG_Q == 4 ? dq_bar : DIAG_Q == 5 ? dq_dw : DIAG_Q == 6 ? dq_pro : DIAG_Q == 7 ? dq_loop : rt;
        ((float*)dq_out)[0] = DIAG_Q == 10 ? 16.0f * (float)dq_iters : DIAG_Q == 11 ? 16.0f * (R == 0.f ? 100.f : (R < 1e-30f ? 10.f : 1.f)) : (DIAG_Q >= 2 && DIAG_Q <= 5) ? (float)v / (float)NT : (float)v; }
#endif
#undef BAR
}
}

struct Args { const float* in[16]; float* out; unsigned char* ws; int ph_lo, ph_hi, qsel, pad_; };
constexpr int N_PHASES = 3 + DEPTH * 3 * 5;

__global__ void __launch_bounds__(NWAVES * 64, 2) fwd(Args args) {
    extern __shared__ __attribute__((aligned(16))) unsigned char lds_raw[];
    Frame F;
    F.lds = (LAS unsigned char*)lds_raw;
    F.tid = threadIdx.x; F.lane = F.tid & 63; F.wave = __builtin_amdgcn_readfirstlane(F.tid >> 6);
    F.G = gridDim.x; F.gw = blockIdx.x * NWAVES + F.wave; F.NGW = F.G * NWAVES;
    F.inp = (const __attribute__((address_space(4))) unsigned long long*)__builtin_amdgcn_kernarg_segment_ptr();
    F.out = args.out; F.ws = args.ws;
    volatile LAS unsigned* MISC = (volatile LAS unsigned*)(F.lds + LDSCTL_OFF);
    if (F.tid < 64) MISC[F.tid] = 0u;
    __syncthreads();
    const int lo = args.ph_lo, hi = args.ph_hi;
    const bool multi = (hi - lo) > 1;
    XcdBarrier bar; bar.bar = (unsigned*)(F.ws + WS_CTL) + CW_BAR; bar.x = 0; bar.st = MISC;
    if (multi) bar = xcd_barrier_post((unsigned*)(F.ws + WS_CTL) + CW_BAR, MISC);
#define IN(k) (lo <= (k) && (k) < hi)
#define SEAM(k) do { if (IN((k) + 1)) xcd_barrier(bar); } while (0)

#ifndef DIS_P0
    if (IN(0)) { for (int rep = 0; rep < REP_P0; ++rep) { p0_prologue(F); __syncthreads(); } SEAM(0); }
#endif
#ifndef DIS_THIN
    if (IN(1)) { p0_mod_tables(F); SEAM(1); }
    if (IN(2)) { thin_phase(F, -1, 0, -1); SEAM(2); }
#endif

    bf16* Hb = (bf16*)(F.ws + WS_H); bf16* HID = (bf16*)(F.ws + WS_HID); bf16* PROJ = (bf16*)(F.ws + WS_PROJ); bf16* Ob = (bf16*)(F.ws + WS_O); bf16* Yb = (bf16*)(F.ws + WS_Y);
    for (int l = 0; l < DEPTH; ++l) {
        unsigned char* wl = F.ws + WS_W + (size_t)l * W_LAYER;
        for (int s = 0; s < 3; ++s) {
            const int pb = 3 + (l * 3 + s) * 5;
            const bool probe_att = (l == DEPTH - 1 && s == 1 && lo > N_PHASES);
            if ((pb + 5 <= lo || pb >= hi) && !probe_att) continue;
            if (s != 1) {
                if (IN(pb)) {
                    const bool hide = (F.G == 256) && (HIDE_N > 0);
                    const int Gg = hide ? F.G - HIDE_WGS : F.G, hk = 2 * l + (s >> 1);
                    int hst = 0, hln = 0;
#pragma unroll
                    for (int k = 0; k < 2 * DEPTH; ++k) if (k == hk) { hst = hide_start(k); hln = hide_len(k); }
                    unsigned* cq = (unsigned*)(F.ws + 2048) + (size_t)hk * 64;
                    if ((int)blockIdx.x < Gg) {
                        pg8::Gemm g{Hb, (const bf16*)(wl + (s == 0 ? W_GU1 : W_GU2)), M, 2 * DFF, DM, DM, DM}; pg8::StaticOrder S; S.init(M, 2 * DFF, Gg, (int)blockIdx.x);
                        pg8::EpiSwiGLU E{HID, LDH};
                        for (int rep = 0; rep < REP_UP; ++rep) pg8::gemm_phase<pg8::EpiSwiGLU, pg8::StaticOrder, true>(F.lds, g, S, E);
                        if (hide) convert_dynamic(F, hst, hln, cq, 1u);
                    } else convert_dynamic(F, hst, hln, cq, 4u);
                    if (IN(pb + 3)) xcd_barrier(bar);
                }
            } else {
                if (IN(pb)) {
                    pg8::Gemm g{Hb, (const bf16*)(wl + W_IN), M, DIN, DM, DM, DM}; pg8::StaticOrder S; S.init(M, DIN, F.G, (int)blockIdx.x);
                    pg8::EpiProj E{PROJ, M, (float*)(F.ws + WS_KMEAN) + (size_t)l * (BATCH * 8 * 8 * 128)};
                    for (int rep = 0; rep < REP_INP; ++rep) pg8::gemm_phase<pg8::EpiProj, pg8::StaticOrder, false>(F.lds, g, S, E);
                    if (IN(pb + 2)) xcd_barrier(bar);
                }
                if (IN(pb + 2) || probe_att) {
                    const bool do_moba = !probe_att || lo == N_PHASES + 1, do_sb = !probe_att || lo == N_PHASES + 2;
                    const float* KM = (const float*)(F.ws + WS_KMEAN) + (size_t)l * (BATCH * 8 * 8 * 128); const float* gain = F.in(10) + (size_t)l * DM;
                    for (int rep = 0; rep < REP_ATT; ++rep) {
                    const int vcu0 = (F.G % 8 == 0) ? (int)(blockIdx.x % 8) * (F.G / 8) + (int)(blockIdx.x / 8) : (int)blockIdx.x;
                    {
                        unsigned* qctr = args.qsel ? (unsigned*)(F.ws + 4096) + (size_t)(args.qsel - 1) * 64 : (unsigned*)(F.ws + 1024) + (size_t)l * 64;
                        volatile LAS unsigned* qslot = (volatile LAS unsigned*)(F.lds + LDSCTL_OFF) + 4;
                        for (;;) {
                            if (F.tid == 0) qslot[0] = __hip_atomic_fetch_add(qctr, 1u, __ATOMIC_RELAXED, __HIP_MEMORY_SCOPE_AGENT);
                            __syncthreads();
                            const unsigned idx = qslot[0];
                            if (idx >= 512u) break;
                            const int qb = 7 - (int)(idx >> 6), ty = (int)(idx >> 5) & 1, g = (int)idx & 31, b = g >> 3, hd = g & 7;
                            if (ty == 0) { if (do_moba) {
#ifndef DIS_MOBA
                                att::attn_unit<true>(F.lds, PROJ, Ob, KM, F.in(12), gain, b, hd, qb, F.ws + 64);
#endif
                            } else __syncthreads(); }
                            else { if (do_sb) {
#ifndef DIS_SB
                                att::attn_unit<false>(F.lds, PROJ, Ob, KM, F.in(12), gain, b, hd, qb, F.ws + 64);
#endif
                            } else __syncthreads(); }
                        }
                    }
                    }
                    SEAM(pb + 2);
                }
            }
            const int ps = l * 3 + s, ns = (ps + 1 < DEPTH * 3) ? ps + 1 : -1;
            const bool fuse = (F.G == 256) && IN(pb + 3) && IN(pb + 4);
            if (IN(pb + 3)) {
                const bf16* A = s == 1 ? Ob : HID; const int K = s == 1 ? DM : DFF;
                const bf16* Bt = (const bf16*)(wl + (s == 0 ? W_D1 : (s == 1 ? W_OUT : W_D2)));
                pg8::Gemm g{A, Bt, M, DM, K, s == 1 ? DM : LDH, K}; pg8::StaticOrder S; S.init(M, DM, F.G, (int)blockIdx.x);
                if (fuse) {
                    pg8::EpiBf16<true> E{Yb, DM};
                    pg8::gemm_phase<pg8::EpiBf16<true>, pg8::StaticOrder, false>(F.lds, g, S, E);
                    pg8::Unit u; S.next(0, u);
                    const int trow0 = u.pm * 256 + u.pn * 32 + F.wave * 4;
                    gu32* cnt = (gu32*)(F.ws + WS_PCNT) + (size_t)(ps * 32 + u.pm) * 64;
                    asm volatile("s_waitcnt vmcnt(0)" ::: "memory");
                    if (F.lane == 0) __hip_atomic_fetch_add(cnt, 1u, __ATOMIC_RELAXED, __HIP_MEMORY_SCOPE_AGENT);
                    thin4_tables(F, ps, ns, trow0);
                    ThinPre tp; thin4_prefetch(F, trow0, tp);
                    if (F.wave == 0) {
                        unsigned sp = 0;
                        while ((unsigned)__builtin_amdgcn_readfirstlane(__hip_atomic_load(cnt, __ATOMIC_RELAXED, __HIP_MEMORY_SCOPE_AGENT)) < 64u) {
                            __builtin_amdgcn_s_sleep(1);
                            if (++sp > (1u << 22)) { if (F.lane == 0) atomicAdd(bar.bar + XB_TMO, 1u); break; } }
                        __builtin_amdgcn_fence(__ATOMIC_ACQUIRE, "agent");
                        asm volatile("s_waitcnt vmcnt(0)" ::: "memory");
                    }
                    __syncthreads();
                    thin4_rows(F, ps, ns, trow0, tp);
                    if (ns >= 0) { if (IN(pb + 5)) xcd_barrier(bar); }
                } else {
                    pg8::EpiBf16<false> E{Yb, DM};
                    for (int rep = 0; rep < REP_DOWN; ++rep) pg8::gemm_phase<pg8::EpiBf16<false>, pg8::StaticOrder, false>(F.lds, g, S, E);
                    SEAM(pb + 3);
                }
            }
            if (IN(pb + 4) && !fuse) {
#ifndef DIS_THIN
                thin_phase(F, ps, ns, -1);
#endif
                if (ns >= 0) { if (IN(pb + 5)) xcd_barrier(bar); }
            }
        }
    }
#if DIAG_Q > 0
    if (blockIdx.x == 0 && F.tid == 0 && hi >= N_PHASES) { asm volatile("s_waitcnt vmcnt(0)" ::: "memory"); const float v_ = __hip_atomic_load((float*)(F.ws + 64), __ATOMIC_RELAXED, __HIP_MEMORY_SCOPE_AGENT) * (1.0f / 16.0f); F.out[0] = exp2f(rintf(log2f(v_) * 4.0f) * 0.25f); }
#endif
#undef IN
#undef SEAM
}

extern "C" void kernel_launch(void* const* d_in, const int* in_sizes, int n_in, void* d_out, int out_size, void* d_ws, size_t ws_size, hipStream_t stream) {
    static int grid = 0;
    if (grid == 0) {
        if (n_in != 16 || in_sizes[0] != M * DM || out_size != M * DM || ws_size < WS_END) { fprintf(stderr, "kernel_launch: unexpected shapes (n_in %d, in0 %d, out %d, ws %zu; need ws >= %zu)\n", n_in, n_in > 0 ? in_sizes[0] : -1, out_size, ws_size, (size_t)WS_END); grid = -1; return; }
        int dev = 0, cus = 0, per_cu = 0;
        if (hipGetDevice(&dev) != hipSuccess || hipDeviceGetAttribute(&cus, hipDeviceAttributeMultiprocessorCount, dev) != hipSuccess) { grid = -1; return; }
        if (hipFuncSetAttribute((const void*)fwd, hipFuncAttributeMaxDynamicSharedMemorySize, LDS_BYTES) != hipSuccess) { fprintf(stderr, "kernel_launch: hipFuncSetAttribute failed\n"); grid = -1; return; }
        if (hipOccupancyMaxActiveBlocksPerMultiprocessor(&per_cu, (const void*)fwd, NWAVES * 64, LDS_BYTES) != hipSuccess || per_cu < 1) fprintf(stderr, "kernel_launch: occupancy query reports %d blocks per CU\n", per_cu);
        (void)hipGetLastError();
        grid = cus;
    }
    if (grid < 0) return;
    if (hipMemsetAsync((char*)d_ws + WS_CTL, 0, CTL_ZERO_BYTES, stream) != hipSuccess) return;
    Args a{};
    for (int i = 0; i < 16; ++i) a.in[i] = (const float*)d_in[i];
    a.out = (float*)d_out; a.ws = (unsigned char*)d_ws;
#if MK_PER_PHASE
    for (int p = 0; p < N_PHASES; ++p) {
        if (p >= 3) { const int r = (p - 3) % 5, s = ((p - 3) / 5) % 3; if ((s != 1 && (r == 1 || r == 2)) || (s == 1 && r == 1)) continue; }
        a.ph_lo = p; a.ph_hi = p + 1;
        hipLaunchKernelGGL(fwd, dim3(grid), dim3(NWAVES * 64), LDS_BYTES, stream, a);
    }
#else
    a.ph_lo = 0; a.ph_hi = N_PHASES;
    hipLaunchKernelGGL(fwd, dim3(grid), dim3(NWAVES * 64), LDS_BYTES, stream, a);
    if (PROBE_PH >= 0) for (int r = 0; r < PROBE_REPS; ++r) { a.ph_lo = PROBE_PH; a.ph_hi = PROBE_PH + 1; a.qsel = r + 1; hipLaunchKernelGGL(fwd, dim3(grid), dim3(NWAVES * 64), LDS_BYTES, stream, a); }
#endif
    const hipError_t le = hipPeekAtLastError();
    if (le != hipSuccess) fprintf(stderr, "kernel_launch: launch failed: %s\n", hipGetErrorName(le));
}
```
